# Optimizing an MI355X kernel written in HIP

```python
import math, functools
import jax
import jax.numpy as jnp
from jax import lax
import numpy as np

D_MODEL = 1024
BATCH = 32
SEQ = 256
DEPTH = 4
DEC_BATCH = 4
DEC_SEQ = 1024
PAST_LEN = 256

GRID_W = 64
N_DIR = 2
D_MIX = D_MODEL
GROUP_W = D_MIX // 4
HEAD_DIM = 64
N_HEADS_G = GROUP_W // HEAD_DIM
D_FF = 4 * D_MODEL
MOD_CH = 6
NORM_EPS = 1e-6
LB_FLOOR = 1e-30
RW_LORA_W = 16
RW_LORA_A = 16
RW_LORA_G = 32
RW_GN_EPS = 64e-5
RW_COLS = 3 * GROUP_W + N_DIR * RW_LORA_W + N_DIR * RW_LORA_A + RW_LORA_G
RW_SPLITS = [GROUP_W, 2 * GROUP_W, 3 * GROUP_W, 3 * GROUP_W + N_DIR * RW_LORA_W,
             3 * GROUP_W + N_DIR * RW_LORA_W + N_DIR * RW_LORA_A]
HG_CHUNK = 16
HG_COLS = 5 * GROUP_W
SSD_GROUPS = 2
SSD_STATE = 128
SSD_CHUNK = 64
SS_CONV_CH = GROUP_W + 2 * SSD_GROUPS * SSD_STATE
SS_COLS = GROUP_W + SS_CONV_CH + N_DIR * N_HEADS_G
LRU_C = 8.0
LR_COLS = 2 * GROUP_W
CONV_W = 4
CONV_PAD_L = 2
CONV_PAD_R = 1
P_IN = RW_COLS + HG_COLS + SS_COLS + LR_COLS

kernel_name = 'hybrid_bidir_recurrent_diffusion_step'


def rms_norm(x, g):
    xf = x.astype(jnp.float32)
    y = xf * lax.rsqrt(jnp.mean(xf * xf, axis=-1, keepdims=True) + NORM_EPS)
    return (y * g.astype(jnp.float32)).astype(x.dtype)


def flip_if(z, d):
    return jnp.flip(z, axis=1) if d == 1 else z


def seq_centred_shift(p):
    half = p.shape[-1] // 2
    prev = jnp.pad(p[:, :-1, :half], ((0, 0), (1, 0), (0, 0)))
    nxt = jnp.pad(p[:, 1:, half:], ((0, 0), (0, 1), (0, 0)))
    return jnp.concatenate([prev, nxt], axis=-1)


def grid_q_shift(p, rows):
    b, t, ch = p.shape
    g = p.reshape(b, rows, GRID_W, ch)
    q = ch // 4
    left = jnp.pad(g[:, :, :-1, :q], ((0, 0), (0, 0), (1, 0), (0, 0)))
    right = jnp.pad(g[:, :, 1:, q:2 * q], ((0, 0), (0, 0), (0, 1), (0, 0)))
    up = jnp.pad(g[:, :-1, :, 2 * q:3 * q], ((0, 0), (1, 0), (0, 0), (0, 0)))
    down = jnp.pad(g[:, 1:, :, 3 * q:], ((0, 0), (0, 1), (0, 0), (0, 0)))
    return jnp.concatenate([left, right, up, down], axis=-1).reshape(b, t, ch)


def centred_dwconv(x, w, b):
    t = x.shape[1]
    xp = jnp.pad(x, ((0, 0), (CONV_PAD_L, CONV_PAD_R), (0, 0)))
    y = b + xp[:, 0:t] * w[0]
    for j in range(1, CONV_W):
        y = y + xp[:, j:j + t] * w[j]
    return y


def modulation(cond, w, b):
    m = jax.nn.silu(cond) @ w + b
    return m.reshape(cond.shape[0], MOD_CH, D_MODEL)


def rwkv7_scan(r, decay, k, v, kk, a, s0):
    def step(s, inp):
        r_t, w_t, k_t, v_t, kk_t, a_t = inp
        sa = jnp.einsum('bhvk,bhk->bhv', s, -kk_t)
        s = s * w_t[:, :, None, :] + sa[..., None] * (kk_t * a_t)[:, :, None, :] + v_t[..., None] * k_t[:, :, None, :]
        return s, jnp.einsum('bhvk,bhk->bhv', s, r_t)
    xs = tuple(jnp.moveaxis(z, 1, 0) for z in (r, decay, k, v, kk, a))
    s_fin, y = lax.scan(step, s0, xs)
    return jnp.moveaxis(y, 0, 1), s_fin


def rwkv7_mix(p, lw, shift_fn, s0):
    bsz, t, _ = p.shape
    heads = lambda z: z.reshape(bsz, t, N_HEADS_G, HEAD_DIM)
    p = (p + (shift_fn(p) - p) * lw['rw_mu']).astype(jnp.float32)
    r, k, v, wd, ad, gd = jnp.split(p, RW_SPLITS, axis=-1)
    g = jax.nn.sigmoid(gd) @ lw['rw_g2']
    kk = heads(k * lw['rw_kk'])
    kk = kk / jnp.maximum(jnp.sqrt(jnp.sum(kk * kk, axis=-1, keepdims=True)), 1e-12)
    rh, vh = heads(r), heads(v)
    ys, ks, finals = [], [], []
    for d in range(N_DIR):
        w_lora = jnp.tanh(wd[..., d * RW_LORA_W:(d + 1) * RW_LORA_W]) @ lw['rw_w2'][d]
        w_log = -jax.nn.softplus(-(lw['rw_w0'][d] + w_lora)) - 0.5
        decay = jnp.exp(-jnp.exp(w_log))
        a = jax.nn.sigmoid(lw['rw_a0'][d] + ad[..., d * RW_LORA_A:(d + 1) * RW_LORA_A] @ lw['rw_a2'][d])
        k_d = k * (1.0 + (a - 1.0) * lw['rw_ka'])
        seqs = [flip_if(z, d) for z in (rh, heads(decay), heads(k_d), vh, kk, heads(a))]
        y_d, s_d = rwkv7_scan(*seqs, s0[:, d].astype(jnp.float32))
        ys.append(flip_if(y_d, d))
        ks.append(k_d)
        finals.append(s_d)
    y = ys[0] + ys[1]
    mu = jnp.mean(y, axis=-1, keepdims=True)
    var = jnp.mean(jnp.square(y - mu), axis=-1, keepdims=True)
    y = ((y - mu) * lax.rsqrt(var + RW_GN_EPS)).reshape(bsz, t, GROUP_W) * lw['rw_ln_w'] + lw['rw_ln_b']
    bonus = jnp.sum(rh * heads(ks[0] + ks[1]) * lw['rw_rk'], axis=-1, keepdims=True) * vh
    out = (y + bonus.reshape(bsz, t, GROUP_W)) * g
    return out, jnp.stack(finals, axis=1)


def gla_chunk_scan(q, k, v, logf, s0):
    bsz, t, h, dk = q.shape
    dv = v.shape[-1]
    nc = t // HG_CHUNK
    q, k, logf = (z.reshape(bsz, nc, HG_CHUNK, h, dk) for z in (q, k, logf))
    v = v.reshape(bsz, nc, HG_CHUNK, h, dv)
    b = jnp.cumsum(logf, axis=2)
    tri = jnp.tril(jnp.ones((HG_CHUNK, HG_CHUNK), dtype=bool))[None, None, :, :, None, None]
    diff = b[:, :, :, None] - b[:, :, None, :]
    rel = jnp.where(tri, jnp.exp(jnp.where(tri, diff, 0.0)), 0.0)
    att = jnp.einsum('bnthk,bntshk,bnshk->bnhts', q, rel, k)
    o_intra = jnp.einsum('bnhts,bnshv->bnthv', att, v)
    b_last = b[:, :, -1]
    q_dec = q * jnp.exp(b)
    k_dec = k * jnp.exp(b_last[:, :, None] - b)
    ds = jnp.einsum('bnshk,bnshv->bnhkv', k_dec, v)

    def step(s, inp):
        dec, d_s = inp
        return dec[..., None] * s + d_s, s
    s_fin, s_prev = lax.scan(step, s0, (jnp.moveaxis(jnp.exp(b_last), 1, 0), jnp.moveaxis(ds, 1, 0)))
    o_inter = jnp.einsum('bnthk,nbhkv->bnthv', q_dec, s_prev)
    return (o_intra + o_inter).reshape(bsz, t, h, dv), s_fin


def hgrn2_mix(p, lw, lb, s0):
    bsz, t, _ = p.shape
    heads = lambda z: z.reshape(bsz, t, N_HEADS_G, HEAD_DIM)
    p = p.astype(jnp.float32)
    q, i, f_fw, f_bw, g = jnp.split(p, 5, axis=-1)
    qh, ih = heads(jax.nn.silu(q)), heads(i)
    ys, finals = [], []
    for d, f_raw in enumerate((f_fw, f_bw)):
        lb_d = lb[d]
        logf = jnp.logaddexp(jnp.log(jnp.maximum(lb_d, LB_FLOOR)), jnp.log1p(-lb_d) + jax.nn.log_sigmoid(f_raw))
        k_d = -jnp.expm1(logf)
        seqs = [flip_if(z, d) for z in (qh, heads(k_d), ih, heads(logf))]
        y_d, s_d = gla_chunk_scan(*seqs, s0[:, d].astype(jnp.float32))
        ys.append(flip_if(y_d, d))
        finals.append(s_d)
    o = (ys[0] + ys[1]).reshape(bsz, t, GROUP_W)
    out = rms_norm(o, lw['hg_norm']) * jax.nn.silu(g)
    return out, jnp.stack(finals, axis=1)


def ssd_chunk_scan(x, dt, a_neg, bm, cm, s0):
    bsz, t, h, pd = x.shape
    nc = t // SSD_CHUNK
    rep = h // SSD_GROUPS
    bh = jnp.repeat(bm, rep, axis=2).reshape(bsz, nc, SSD_CHUNK, h, SSD_STATE)
    ch = jnp.repeat(cm, rep, axis=2).reshape(bsz, nc, SSD_CHUNK, h, SSD_STATE)
    x = x.reshape(bsz, nc, SSD_CHUNK, h, pd)
    dt = dt.reshape(bsz, nc, SSD_CHUNK, h)
    acum = jnp.cumsum(dt * a_neg, axis=2)
    tri = jnp.tril(jnp.ones((SSD_CHUNK, SSD_CHUNK), dtype=bool))[None, None, :, :, None]
    seg = acum[:, :, :, None, :] - acum[:, :, None, :, :]
    decay_ts = jnp.where(tri, jnp.exp(jnp.where(tri, seg, 0.0)), 0.0)
    xdt = x * dt[..., None]
    cb = jnp.einsum('bzthn,bzshn->bztsh', ch, bh)
    y_diag = jnp.einsum('bztsh,bzshp->bzthp', cb * decay_ts, xdt)
    a_last = acum[:, :, -1]
    ds = jnp.einsum('bzshn,bzsh,bzshp->bzhpn', bh, jnp.exp(a_last[:, :, None] - acum), xdt)

    def step(s, inp):
        dec, d_s = inp
        return dec[..., None, None] * s + d_s, s
    s_fin, s_prev = lax.scan(step, s0, (jnp.moveaxis(jnp.exp(a_last), 1, 0), jnp.moveaxis(ds, 1, 0)))
    y_off = jnp.einsum('bzthn,zbhpn->bzthp', ch, s_prev) * jnp.exp(acum)[..., None]
    return (y_diag + y_off).reshape(bsz, t, h, pd), s_fin


def ssd_mix(p, lw, s0):
    bsz, t, _ = p.shape
    z, xbc, dtr = jnp.split(p, [GROUP_W, GROUP_W + SS_CONV_CH], axis=-1)
    xbc = jax.nn.silu(centred_dwconv(xbc, lw['ss_conv_w'], lw['ss_conv_b'])).astype(jnp.float32)
    xs, bm, cm = jnp.split(xbc, [GROUP_W, GROUP_W + SSD_GROUPS * SSD_STATE], axis=-1)
    xh = xs.reshape(bsz, t, N_HEADS_G, HEAD_DIM)
    bm = bm.reshape(bsz, t, SSD_GROUPS, SSD_STATE)
    cm = cm.reshape(bsz, t, SSD_GROUPS, SSD_STATE)
    ys, finals = [], []
    for d in range(N_DIR):
        dt = jax.nn.softplus(dtr[..., d * N_HEADS_G:(d + 1) * N_HEADS_G].astype(jnp.float32) + lw['ss_dt_bias'][d])
        a_neg = -jnp.exp(lw['ss_A_log'][d].astype(jnp.float32))
        y_d, s_d = ssd_chunk_scan(flip_if(xh, d), flip_if(dt, d), a_neg, flip_if(bm, d), flip_if(cm, d),
                                  s0[:, d].astype(jnp.float32))
        ys.append(flip_if(y_d, d))
        finals.append(s_d)
    y = ys[0] + ys[1] + lw['ss_D'][:, None] * xh
    out = rms_norm(y.reshape(bsz, t, GROUP_W) * jax.nn.silu(z.astype(jnp.float32)), lw['ss_norm'])
    return out, jnp.stack(finals, axis=1)


def diag_linear_scan(a, b, h0):
    b = b.at[:, 0].add(a[:, 0] * h0)

    def comb(l, r):
        return (l[0] * r[0], r[0] * l[1] + r[1])
    _, h = lax.associative_scan(comb, (a, b), axis=1)
    return h, h[:, -1]


def rglru_mix(p, lw, s0):
    bsz, t, _ = p.shape
    ybr, xbr = jnp.split(p, 2, axis=-1)
    xc = centred_dwconv(xbr, lw['lr_conv_w'], lw['lr_conv_b']).astype(jnp.float32)
    xh = xc.reshape(bsz, t, N_HEADS_G, HEAD_DIM)
    hs, finals = [], []
    for d in range(N_DIR):
        r = jax.nn.sigmoid(jnp.einsum('bthi,hij->bthj', xh, lw['lr_wa'][d]).reshape(bsz, t, GROUP_W) + lw['lr_ba'][d])
        i = jax.nn.sigmoid(jnp.einsum('bthi,hij->bthj', xh, lw['lr_wx'][d]).reshape(bsz, t, GROUP_W) + lw['lr_bx'][d])
        log_a = -LRU_C * r * jax.nn.softplus(-lw['lr_lam'][d].astype(jnp.float32))
        a = jnp.exp(log_a)
        b = jnp.sqrt(jnp.maximum(-jnp.expm1(2.0 * log_a), 0.0)) * (i * xc)
        h_d, s_d = diag_linear_scan(flip_if(a, d), flip_if(b, d), s0[:, d].astype(jnp.float32))
        hs.append(flip_if(h_d, d))
        finals.append(s_d)
    out = (hs[0] + hs[1]) * jax.nn.gelu(ybr.astype(jnp.float32))
    return out, jnp.stack(finals, axis=1)


def trunk_layer(x, mod, lw, lb, shift_fn, states):
    sh1, sc1, g1, sh2, sc2, g2 = (mod[:, i, None, :] for i in range(MOD_CH))
    h = rms_norm(x, lw['g_pre1']) * (1 + sc1) + sh1
    proj = h @ lw['w_in']
    p_rw, p_hg, p_ss, p_lr = jnp.split(proj, [RW_COLS, RW_COLS + HG_COLS, RW_COLS + HG_COLS + SS_COLS], axis=-1)
    s_rw, s_hg, s_ss, s_lr = states
    y_rw, f_rw = rwkv7_mix(p_rw, lw, shift_fn, s_rw)
    y_hg, f_hg = hgrn2_mix(p_hg, lw, lb, s_hg)
    y_ss, f_ss = ssd_mix(p_ss, lw, s_ss)
    y_lr, f_lr = rglru_mix(p_lr, lw, s_lr)
    mix = jnp.concatenate([y_rw, y_hg, y_ss, y_lr], axis=-1).astype(x.dtype) @ lw['w_out']
    x = x + g1 * rms_norm(mix, lw['g_post1'])
    h = rms_norm(x, lw['g_pre2']) * (1 + sc2) + sh2
    ff = jnp.square(jax.nn.relu(h @ lw['w1'])) @ lw['w2']
    x = x + g2 * rms_norm(ff, lw['g_post2'])
    return x, (f_rw, f_hg, f_ss, f_lr)


def setup_inputs(seed: int = 0) -> dict:
    key = jax.random.key(seed)
    ks = iter(jax.random.split(key, 64))
    f32 = jnp.float32

    def nrm(shape, scale=1.0):
        return scale * jax.random.normal(next(ks), shape, f32)

    def uni(shape, lo, hi):
        return jax.random.uniform(next(ks), shape, f32, lo, hi)
    H = N_HEADS_G
    dt0 = jnp.exp(uni((DEPTH, N_DIR, H), math.log(1e-3), math.log(1e-1)))
    lam_u = uni((DEPTH, N_DIR, GROUP_W), 0.9, 0.999) ** (1.0 / LRU_C)
    return {
        'x_prompt': nrm((BATCH, SEQ, D_MODEL)),
        'x_sample': nrm((DEC_BATCH, DEC_SEQ, D_MODEL)),
        'state_rwkv': nrm((DEC_BATCH, DEPTH, N_DIR, H, HEAD_DIM, HEAD_DIM), 0.5),
        'state_hgrn': nrm((DEC_BATCH, DEPTH, N_DIR, H, HEAD_DIM, HEAD_DIM), 0.5),
        'state_ssd': nrm((DEC_BATCH, DEPTH, N_DIR, H, HEAD_DIM, SSD_STATE), 0.5),
        'state_lru': nrm((DEC_BATCH, DEPTH, N_DIR, GROUP_W), 0.5),
        'c': nrm((DEC_BATCH, D_MODEL)),
        'c_ctx': nrm((D_MODEL,)),
        'mod_w': nrm((DEPTH, D_MODEL, MOD_CH * D_MODEL), 0.5 * D_MODEL ** -0.5),
        'mod_b': nrm((DEPTH, MOD_CH * D_MODEL), 0.01),
        'norm_g': 1.0 + nrm((DEPTH, 4, D_MODEL), 0.02),
        'w_in': nrm((DEPTH, D_MODEL, P_IN), D_MODEL ** -0.5),
        'w_out': nrm((DEPTH, D_MIX, D_MODEL), D_MIX ** -0.5),
        'rw_mu': uni((DEPTH, RW_COLS), 0.0, 1.0),
        'rw_w0': uni((DEPTH, N_DIR, GROUP_W), -4.0, -1.0),
        'rw_w2': nrm((DEPTH, N_DIR, RW_LORA_W, GROUP_W), 0.1),
        'rw_a0': nrm((DEPTH, N_DIR, GROUP_W), 0.1),
        'rw_a2': nrm((DEPTH, N_DIR, RW_LORA_A, GROUP_W), 0.1),
        'rw_g2': nrm((DEPTH, RW_LORA_G, GROUP_W), RW_LORA_G ** -0.5),
        'rw_kk': 0.85 + nrm((DEPTH, GROUP_W), 0.02),
        'rw_ka': 1.0 + nrm((DEPTH, GROUP_W), 0.02),
        'rw_rk': nrm((DEPTH, H, HEAD_DIM), 0.1),
        'rw_ln_w': 1.0 + nrm((DEPTH, GROUP_W), 0.02),
        'rw_ln_b': nrm((DEPTH, GROUP_W), 0.01),
        'hg_lb': 1.0 + nrm((DEPTH, N_DIR, GROUP_W), 0.1),
        'hg_norm': 1.0 + nrm((DEPTH, GROUP_W), 0.02),
        'ss_conv_w': nrm((DEPTH, CONV_W, SS_CONV_CH), CONV_W ** -0.5),
        'ss_conv_b': nrm((DEPTH, SS_CONV_CH), 0.01),
        'ss_dt_bias': dt0 + jnp.log(-jnp.expm1(-dt0)),
        'ss_A_log': jnp.log(uni((DEPTH, N_DIR, H), 1.0, 16.0)),
        'ss_D': 1.0 + nrm((DEPTH, H), 0.02),
        'ss_norm': 1.0 + nrm((DEPTH, GROUP_W), 0.02),
        'lr_conv_w': nrm((DEPTH, CONV_W, GROUP_W), CONV_W ** -0.5),
        'lr_conv_b': nrm((DEPTH, GROUP_W), 0.01),
        'lr_wa': nrm((DEPTH, N_DIR, H, HEAD_DIM, HEAD_DIM), HEAD_DIM ** -0.5),
        'lr_ba': nrm((DEPTH, N_DIR, GROUP_W), 0.01),
        'lr_wx': nrm((DEPTH, N_DIR, H, HEAD_DIM, HEAD_DIM), HEAD_DIM ** -0.5),
        'lr_bx': nrm((DEPTH, N_DIR, GROUP_W), 0.01),
        'lr_lam': jnp.log(lam_u) - jnp.log1p(-lam_u),
        'mlp_w1': nrm((DEPTH, D_MODEL, D_FF), D_MODEL ** -0.5),
        'mlp_w2': nrm((DEPTH, D_FF, D_MODEL), D_FF ** -0.5),
    }


def reference(x_prompt, x_sample, state_rwkv, state_hgrn, state_ssd, state_lru, c, c_ctx,
              mod_w, mod_b, norm_g, w_in, w_out,
              rw_mu, rw_w0, rw_w2, rw_a0, rw_a2, rw_g2, rw_kk, rw_ka, rw_rk, rw_ln_w, rw_ln_b,
              hg_lb, hg_norm,
              ss_conv_w, ss_conv_b, ss_dt_bias, ss_A_log, ss_D, ss_norm,
              lr_conv_w, lr_conv_b, lr_wa, lr_ba, lr_wx, lr_bx, lr_lam,
              mlp_w1, mlp_w2):
    f32 = jnp.float32
    lb_soft = jax.nn.softmax(hg_lb.astype(f32), axis=0)
    lower_bounds = jnp.cumsum(lb_soft, axis=0) - lb_soft[0]
    rows = x_sample.shape[1] // GRID_W
    latent_shift = functools.partial(grid_q_shift, rows=rows)
    bp = x_prompt.shape[0]
    zero_states = (jnp.zeros((bp, N_DIR, N_HEADS_G, HEAD_DIM, HEAD_DIM), f32),
                   jnp.zeros((bp, N_DIR, N_HEADS_G, HEAD_DIM, HEAD_DIM), f32),
                   jnp.zeros((bp, N_DIR, N_HEADS_G, HEAD_DIM, SSD_STATE), f32),
                   jnp.zeros((bp, N_DIR, GROUP_W), f32))
    xp, xs = x_prompt, x_sample
    new_rw, new_hg, new_ss, new_lr = [], [], [], []
    for l in range(DEPTH):
        lw = {
            'w_in': w_in[l], 'w_out': w_out[l],
            'g_pre1': norm_g[l, 0], 'g_post1': norm_g[l, 1], 'g_pre2': norm_g[l, 2], 'g_post2': norm_g[l, 3],
            'w1': mlp_w1[l], 'w2': mlp_w2[l],
            'rw_mu': rw_mu[l], 'rw_w0': rw_w0[l], 'rw_w2': rw_w2[l], 'rw_a0': rw_a0[l], 'rw_a2': rw_a2[l],
            'rw_g2': rw_g2[l], 'rw_kk': rw_kk[l], 'rw_ka': rw_ka[l], 'rw_rk': rw_rk[l],
            'rw_ln_w': rw_ln_w[l], 'rw_ln_b': rw_ln_b[l],
            'hg_norm': hg_norm[l],
            'ss_conv_w': ss_conv_w[l], 'ss_conv_b': ss_conv_b[l], 'ss_dt_bias': ss_dt_bias[l],
            'ss_A_log': ss_A_log[l], 'ss_D': ss_D[l], 'ss_norm': ss_norm[l],
            'lr_conv_w': lr_conv_w[l], 'lr_conv_b': lr_conv_b[l], 'lr_wa': lr_wa[l], 'lr_ba': lr_ba[l],
            'lr_wx': lr_wx[l], 'lr_bx': lr_bx[l], 'lr_lam': lr_lam[l],
        }
        mod_ctx = modulation(c_ctx[None, :], mod_w[l], mod_b[l])
        mod_lat = modulation(c, mod_w[l], mod_b[l])
        xp, (f_rw, f_hg, f_ss, f_lr) = trunk_layer(xp, mod_ctx, lw, lower_bounds[l], seq_centred_shift, zero_states)
        new_rw.append(f_rw)
        new_hg.append(f_hg)
        new_ss.append(f_ss)
        new_lr.append(f_lr)
        cached = (state_rwkv[:, l], state_hgrn[:, l], state_ssd[:, l], state_lru[:, l])
        xs, _ = trunk_layer(xs, mod_lat, lw, lower_bounds[l], latent_shift, cached)
    new_state_rwkv = jnp.stack(new_rw, axis=1).astype(x_prompt.dtype)
    new_state_hgrn = jnp.stack(new_hg, axis=1).astype(x_prompt.dtype)
    new_state_ssd = jnp.stack(new_ss, axis=1).astype(x_prompt.dtype)
    new_state_lru = jnp.stack(new_lr, axis=1).astype(x_prompt.dtype)
    return (xp, xs, new_state_rwkv, new_state_hgrn, new_state_ssd, new_state_lru)
```

```cpp
#include <hip/hip_runtime.h>
#include <cstdio>
#include <cstdint>
namespace pg8 {
#define PG8_LAS __attribute__((address_space(3)))
typedef unsigned short bf16_t;
typedef short bf16x8 __attribute__((ext_vector_type(8)));
typedef float f32x4 __attribute__((ext_vector_type(4)));
typedef unsigned u32x4 __attribute__((ext_vector_type(4)));
constexpr int BM = 256, BK = 64, HALF = 128, HTB = HALF * BK * 2  , STAGE_BYTES = 8 * HTB, NXCD = 8, WGM = 8;

__host__ __device__ __forceinline__ int lds_byte(int r, int c) { const int st = (r >> 4) * 2 + (c >> 5), rr = r & 15, cc = c & 31, ob = rr * 64 + cc * 2; return st * 1024 + (ob ^ (((ob >> 9) & 1) << 5)); }
__host__ __device__ __forceinline__ void stage_rc(int b, int& R, int& C) { const int st = b / 1024, sb = b % 1024, swz = sb ^ (((sb >> 9) & 1) << 5); R = (st >> 1) * 16 + swz / 64; C = (st & 1) * 32 + (swz % 64) / 2; }
__host__ __device__ __forceinline__ int perm32(int rho) { const int n = rho >> 4, i = rho & 15; return 8 * (i >> 2) + 4 * n + (i & 3); }

struct Unit { int pm, pn; };
struct Gemm { const bf16_t* A; const bf16_t* Bt; int M, N, K; };

struct StaticOrder {
    int nM, nN, nwg, G, c;
    __host__ __device__ void init(int M, int N, int G_, int c_) { nM = M / BM; nN = N / BM; nwg = nM * nN; G = G_; c = c_; }
    __host__ __device__ bool next(int i, Unit& u) const {
        const long L = (long)i * G + c; if (L >= nwg) return false;
        int wgid = (int)L; { const int q = nwg / NXCD, r = nwg % NXCD, xcd = wgid % NXCD, off = wgid / NXCD; wgid = (xcd < r ? xcd * (q + 1) : r * (q + 1) + (xcd - r) * q) + off; }
        const int nig = WGM * nN, gid = wgid / nig, fm = gid * WGM, gsz = (nM - fm) < WGM ? (nM - fm) : WGM;
        u.pm = fm + ((wgid % nig) % gsz); u.pn = (wgid % nig) / gsz; return true;
    }
    __device__ __forceinline__ void a_ready(const Unit&) const {}
    __device__ __forceinline__ void done(const Unit&) const {}
};

__device__ __forceinline__ unsigned cvt_pk_bf16(float lo, float hi) { unsigned r; asm volatile("v_cvt_pk_bf16_f32 %0, %1, %2" : "=v"(r) : "v"(lo), "v"(hi)); return r; }
typedef float f32x2 __attribute__((ext_vector_type(2)));
__device__ __forceinline__ f32x2 gelu_pk(f32x2 v) {
    const f32x2 av = __builtin_elementwise_abs(v), d = av * 0.2316418882f + 1.0f;
    f32x2 t; t.x = __builtin_amdgcn_rcpf(d.x); t.y = __builtin_amdgcn_rcpf(d.y);
    f32x2 q = t * 0.5307027145f + (-0.7265760135f); q = q * t + 0.7107068705f; q = q * t + (-0.142248368f); q = q * t + 0.127414796f; q = q * t;
    const f32x2 s = (v * v) * (-0.72134752044f);
    f32x2 e; e.x = __builtin_amdgcn_exp2f(s.x); e.y = __builtin_amdgcn_exp2f(s.y);
    const f32x2 m = v * (q * e), r = v - m;
    f32x2 o; o.x = v.x < 0.f ? m.x : r.x; o.y = v.y < 0.f ? m.y : r.y; return o;
}

template <int ACT  > struct EpiBf16 {
    static constexpr bool PERM = true, AFTER_DRAIN = false;
    bf16_t* O; int ldc;
    __device__ __forceinline__ void operator()(const f32x4 (&acc)[2][2][4][2], const Unit& u, int wr, int wc, int fr, int fq) const {
        const int row0 = u.pm * BM + wr * 64 + fr; const int col0 = u.pn * BM + wc * 32 + 8 * fq;
#pragma unroll
        for (int ai = 0; ai < 2; ++ai)
#pragma unroll
            for (int m = 0; m < 4; ++m) { bf16_t* rowp = O + (size_t)(row0 + ai * HALF + m * 16) * ldc + col0;
#pragma unroll
                for (int bj = 0; bj < 2; ++bj) { f32x4 v0 = acc[ai][bj][m][0], v1 = acc[ai][bj][m][1];
                    if (ACT == 2) {
#pragma unroll
                        for (int e = 0; e < 4; ++e) { float a = fmaxf(v0[e], 0.f), b = fmaxf(v1[e], 0.f); v0[e] = a * a; v1[e] = b * b; } }
                    u32x4 w; w.x = cvt_pk_bf16(v0[0], v0[1]); w.y = cvt_pk_bf16(v0[2], v0[3]); w.z = cvt_pk_bf16(v1[0], v1[1]); w.w = cvt_pk_bf16(v1[2], v1[3]);
                    *(u32x4*)(rowp + bj * HALF) = w; } }
    }
};
struct EpiF32 {
    static constexpr bool PERM = false, AFTER_DRAIN = false;
    float* O; int ldc;
    __device__ __forceinline__ void operator()(const f32x4 (&acc)[2][2][4][2], const Unit& u, int wr, int wc, int fr, int fq) const {
        const int col0 = u.pn * BM + wc * 32 + 4 * fq;
#pragma unroll
        for (int ai = 0; ai < 2; ++ai)
#pragma unroll
            for (int m = 0; m < 4; ++m) { const size_t off = (size_t)(u.pm * BM + ai * HALF + wr * 64 + m * 16 + fr) * ldc + col0;
#pragma unroll
                for (int bj = 0; bj < 2; ++bj)
#pragma unroll
                    for (int n = 0; n < 2; ++n) *(f32x4*)(O + off + bj * HALF + n * 16) = acc[ai][bj][m][n]; }
    }
};
template <class Epi, class Sched, bool ALIGN_EPI = false, bool SP2 = false>
__device__ __forceinline__ void gemm_phase(PG8_LAS unsigned char* lds, const Gemm g, const Sched& S, const Epi& E) {
    int tid_ = threadIdx.x; asm volatile("" : "+v"(tid_));
    const int tid = tid_, wid = __builtin_amdgcn_readfirstlane(tid >> 6), lane = tid & 63, wr = wid >> 2, wc = wid & 3, fr = lane & 15, fq = lane >> 4;
    const int K = g.K, nt = K / BK;
    unsigned voffA[2], voffB[2];
#pragma unroll
    for (int i = 0; i < 2; ++i) { int R, C; stage_rc(tid * 16 + i * 8192, R, C); const int Rb = Epi::PERM ? ((R & ~31) + perm32(R & 31)) : R;
        voffA[i] = (unsigned)(R * K + C) * 2u; voffB[i] = (unsigned)(Rb * K + C) * 2u; }
    const size_t kstep = (size_t)(BK * 2);
    const size_t hstep = (size_t)HALF * K * 2;
    const size_t tstep = 2 * hstep;
    const unsigned ldsw = (unsigned)wid * 1024u;
    const int aoff = lds_byte(wr * 64 + fr, fq * 8), boff = lds_byte(wc * 32 + fr, fq * 8);
#define PG8_SA(b, h) (((b) * 2 + (h)) * HTB)
#define PG8_SB(b, h) ((4 + (b) * 2 + (h)) * HTB)
#define PG8_STAGE(bufoff, gbase, voff) do { _Pragma("unroll") for (int _i = 0; _i < 2; ++_i) \
        __builtin_amdgcn_global_load_lds((const unsigned*)((const char*)(gbase) + (voff)[_i]), (PG8_LAS unsigned*)(lds + (bufoff) + ldsw + _i * 8192), 16, 0, 0); } while (0)
#define PG8_LDA(dst, b, h) do { _Pragma("unroll") for (int m = 0; m < 4; ++m) _Pragma("unroll") for (int k = 0; k < 2; ++k) dst[m][k] = *(const PG8_LAS bf16x8*)(lds + PG8_SA(b, h) + aoff + m * 2048 + k * 1024); } while (0)
#define PG8_LDB(dst, b, h) do { _Pragma("unroll") for (int n = 0; n < 2; ++n) _Pragma("unroll") for (int k = 0; k < 2; ++k) dst[n][k] = *(const PG8_LAS bf16x8*)(lds + PG8_SB(b, h) + boff + n * 2048 + k * 1024); } while (0)
#define PG8_MMA(ai, bj, At, Bt) do { __builtin_amdgcn_s_setprio(1); _Pragma("unroll") for (int m = 0; m < 4; ++m) _Pragma("unroll") for (int n = 0; n < 2; ++n) _Pragma("unroll") for (int k = 0; k < 2; ++k) \
        acc[ai][bj][m][n] = __builtin_amdgcn_mfma_f32_16x16x32_bf16(Bt[n][k], At[m][k], acc[ai][bj][m][n], 0, 0, 0); __builtin_amdgcn_s_setprio(0); } while (0)
#define PG8_WAIT_V(n) asm volatile("s_waitcnt vmcnt(" #n ")" ::: "memory")
#define PG8_WAIT_L(n) asm volatile("s_waitcnt lgkmcnt(" #n ")" ::: "memory")
#define PG8_BAR __builtin_amdgcn_s_barrier()
#define PG8_SCHED __builtin_amdgcn_sched_barrier(0)
    Unit cur, nxt; int ui = 0;
    if (!S.next(0, cur)) return;
    f32x4 acc[2][2][4][2];
#pragma unroll
    for (int a = 0; a < 2; ++a)
#pragma unroll
        for (int b = 0; b < 2; ++b)
#pragma unroll
            for (int m = 0; m < 4; ++m)
#pragma unroll
                for (int n = 0; n < 2; ++n) acc[a][b][m][n] = (f32x4){0.f, 0.f, 0.f, 0.f};
    bf16x8 At[4][2], B0[2][2], B1[2][2];
    const char* cA = (const char*)g.A + (size_t)cur.pm * tstep; const char* cB = (const char*)g.Bt + (size_t)cur.pn * tstep;
    S.a_ready(cur);
    if constexpr (SP2) {
        PG8_STAGE(PG8_SB(0, 0), cB, voffB); PG8_STAGE(PG8_SB(0, 1), cB + hstep, voffB); PG8_STAGE(PG8_SA(0, 0), cA, voffA); PG8_STAGE(PG8_SA(0, 1), cA + hstep, voffA);
        if (wr == 1) PG8_BAR;
        PG8_WAIT_V(2); PG8_BAR;
        PG8_STAGE(PG8_SB(1, 0), cB + kstep, voffB); PG8_STAGE(PG8_SA(1, 0), cA + kstep, voffA); PG8_STAGE(PG8_SB(1, 1), cB + hstep + kstep, voffB);
        PG8_WAIT_V(6); PG8_BAR;
    } else {
        PG8_STAGE(PG8_SB(0, 0), cB, voffB); PG8_STAGE(PG8_SA(0, 0), cA, voffA); PG8_STAGE(PG8_SB(0, 1), cB + hstep, voffB); PG8_STAGE(PG8_SA(0, 1), cA + hstep, voffA);
        if (wr == 1) PG8_BAR;
        PG8_WAIT_V(4); PG8_BAR;
        PG8_STAGE(PG8_SB(1, 0), cB + kstep, voffB); PG8_STAGE(PG8_SA(1, 0), cA + kstep, voffA); PG8_STAGE(PG8_SB(1, 1), cB + hstep + kstep, voffB);
        PG8_WAIT_V(6); PG8_BAR;
    }
    for (;;) {
        const bool has_next = S.next(ui + 1, nxt);
        const char* nA = has_next ? (const char*)g.A + (size_t)nxt.pm * tstep : cA; const char* nB = has_next ? (const char*)g.Bt + (size_t)nxt.pn * tstep : cB;
        for (int t = 0; t < nt; t += 2) {
            const bool last = (t == nt - 2);
            const char* a1 = cA + (size_t)(t + 1) * kstep;
            const char* a2 = last ? nA : cA + (size_t)(t + 2) * kstep; const char* b2 = last ? nB : cB + (size_t)(t + 2) * kstep;
            const char* a3 = a2 + kstep; const char* b3 = b2 + kstep;
            if (last && has_next) S.a_ready(nxt);
            if constexpr (SP2) {
            PG8_LDB(B0, 0, 0); PG8_LDB(B1, 0, 1); PG8_SCHED; PG8_LDA(At, 0, 0); PG8_STAGE(PG8_SA(1, 1), a1 + hstep, voffA);
            PG8_WAIT_V(8); PG8_WAIT_L(0); PG8_BAR; PG8_MMA(0, 0, At, B0); PG8_MMA(0, 1, At, B1); PG8_BAR; PG8_SCHED;
            PG8_LDA(At, 0, 1); PG8_STAGE(PG8_SB(0, 0), b2, voffB); PG8_STAGE(PG8_SB(0, 1), b2 + hstep, voffB); PG8_STAGE(PG8_SA(0, 0), a2, voffA);
            PG8_WAIT_V(8); PG8_WAIT_L(0); PG8_BAR; PG8_MMA(1, 0, At, B0); PG8_MMA(1, 1, At, B1); PG8_BAR; PG8_SCHED;
            PG8_LDB(B0, 1, 0); PG8_LDB(B1, 1, 1); PG8_SCHED; PG8_LDA(At, 1, 0); PG8_STAGE(PG8_SA(0, 1), a2 + hstep, voffA);
            PG8_WAIT_V(8); PG8_WAIT_L(0); PG8_BAR; PG8_MMA(0, 0, At, B0); PG8_MMA(0, 1, At, B1); PG8_BAR; PG8_SCHED;
            PG8_LDA(At, 1, 1); PG8_STAGE(PG8_SB(1, 0), b3, voffB); PG8_STAGE(PG8_SB(1, 1), b3 + hstep, voffB); PG8_STAGE(PG8_SA(1, 0), a3, voffA);
            PG8_WAIT_V(8); PG8_WAIT_L(0); PG8_BAR; PG8_MMA(1, 0, At, B0); PG8_MMA(1, 1, At, B1); PG8_BAR; PG8_SCHED;
            } else {
            PG8_LDB(B0, 0, 0); PG8_SCHED; PG8_LDA(At, 0, 0); PG8_STAGE(PG8_SA(1, 1), a1 + hstep, voffA);
            PG8_WAIT_L(8); PG8_BAR; PG8_WAIT_L(0); PG8_MMA(0, 0, At, B0); PG8_BAR; PG8_SCHED;
            PG8_LDB(B1, 0, 1); PG8_STAGE(PG8_SB(0, 0), b2, voffB);
            PG8_BAR; PG8_WAIT_L(0); PG8_MMA(0, 1, At, B1); PG8_BAR;
            PG8_LDA(At, 0, 1); PG8_STAGE(PG8_SA(0, 0), a2, voffA);
            PG8_BAR; PG8_WAIT_L(0); PG8_MMA(1, 0, At, B0); PG8_BAR; PG8_SCHED;
            PG8_STAGE(PG8_SB(0, 1), b2 + hstep, voffB);
            PG8_WAIT_V(6); PG8_BAR; PG8_MMA(1, 1, At, B1); PG8_BAR;
            PG8_LDB(B0, 1, 0); PG8_SCHED; PG8_LDA(At, 1, 0); PG8_STAGE(PG8_SA(0, 1), a2 + hstep, voffA);
            PG8_WAIT_L(8); PG8_BAR; PG8_WAIT_L(0); PG8_MMA(0, 0, At, B0); PG8_BAR; PG8_SCHED;
            PG8_LDB(B1, 1, 1); PG8_STAGE(PG8_SB(1, 0), b3, voffB);
            PG8_BAR; PG8_WAIT_L(0); PG8_MMA(0, 1, At, B1); PG8_BAR;
            PG8_LDA(At, 1, 1); PG8_STAGE(PG8_SA(1, 0), a3, voffA);
            PG8_BAR; PG8_WAIT_L(0); PG8_MMA(1, 0, At, B0); PG8_BAR; PG8_SCHED;
            PG8_STAGE(PG8_SB(1, 1), b3 + hstep, voffB);
            PG8_WAIT_V(6); PG8_BAR; PG8_MMA(1, 1, At, B1); PG8_BAR;
            }
        }
        if constexpr (ALIGN_EPI) { if (wr == 0) PG8_BAR; }
        if constexpr (!Epi::AFTER_DRAIN) { E(acc, cur, wr, wc, fr, fq); S.done(cur); }
        if (!has_next) break;
#pragma unroll
        for (int a = 0; a < 2; ++a)
#pragma unroll
            for (int b = 0; b < 2; ++b)
#pragma unroll
                for (int m = 0; m < 4; ++m)
#pragma unroll
                    for (int n = 0; n < 2; ++n) acc[a][b][m][n] = (f32x4){0.f, 0.f, 0.f, 0.f};
        cur = nxt; cA = nA; cB = nB; ++ui;
        if constexpr (ALIGN_EPI) { if (wr == 1) PG8_BAR; }
    }
    PG8_WAIT_V(0);
    if constexpr (!ALIGN_EPI) { if (wr == 0) PG8_BAR; }
    PG8_BAR;
    if constexpr (Epi::AFTER_DRAIN) { E.fused(acc, cur, wr, wc, fr, fq, lds, wid, lane); S.done(cur); }
#undef PG8_SA
#undef PG8_SB
#undef PG8_STAGE
#undef PG8_LDA
#undef PG8_LDB
#undef PG8_MMA
#undef PG8_WAIT_V
#undef PG8_WAIT_L
#undef PG8_BAR
#undef PG8_SCHED
}
}

#ifndef PG8_SP2
#define PG8_SP2 true
#endif
#ifndef PG8_ALIGN
#define PG8_ALIGN true
#endif
#if defined(__HIP_DEVICE_COMPILE__)
#define GAS __attribute__((address_space(1)))
#else
#define GAS
#endif
#define LAS __attribute__((address_space(3)))
typedef unsigned short bf16;
typedef unsigned v4u __attribute__((ext_vector_type(4)));
typedef float f32x4 __attribute__((ext_vector_type(4)));
typedef short bf16x8 __attribute__((ext_vector_type(8)));
typedef GAS unsigned gu32;
typedef GAS unsigned long long gu64;
#define RLX_AGENT __ATOMIC_RELAXED, __HIP_MEMORY_SCOPE_AGENT
#define LDS_WAIT() asm volatile("s_waitcnt lgkmcnt(0)" ::: "memory")
#define VM_WAIT() asm volatile("s_waitcnt vmcnt(0)" ::: "memory")
__device__ __forceinline__ unsigned long long rt() { return __builtin_amdgcn_s_memrealtime(); }
__device__ __forceinline__ unsigned f2bf(float f) { unsigned u = __builtin_bit_cast(unsigned, f); return (u + 0x7fffu + ((u >> 16) & 1u)) >> 16; }
__device__ __forceinline__ unsigned pk2(float lo, float hi) { return f2bf(lo) | (f2bf(hi) << 16); }

#define XB_TMO      128
#define XB_XCNT(j)  (256  + 64 * (j))
#define XB_XSUB(j)  (1280 + 64 * (j))
#define XB_XGEN(j)  (2304 + 64 * (j))
#define XB_TOP      3328
#define XB_TOPGEN   3392
#define XCD_BAR_WORDS 3456
#define XB_SPIN_CAP (1u << 18)

__device__ __forceinline__ unsigned xb_ld(unsigned* p)              { return __hip_atomic_load(p, __ATOMIC_RELAXED, __HIP_MEMORY_SCOPE_AGENT); }
__device__ __forceinline__ unsigned xb_add(unsigned* p, unsigned v) { return __hip_atomic_fetch_add(p, v, __ATOMIC_RELAXED, __HIP_MEMORY_SCOPE_AGENT); }
__device__ __forceinline__ unsigned xb_xcc_id() { return (unsigned)__builtin_amdgcn_s_getreg((3 << 11) | 20) & 0xFu; }
#define XB_SPIN(cond, bar) do { unsigned _sp = 0; while (cond) { __builtin_amdgcn_s_sleep(1); \
    if ((++_sp & 255u) == 0u) { if (xb_ld(&(bar)[XB_TMO])) break; if (_sp > XB_SPIN_CAP) { atomicAdd(&(bar)[XB_TMO], 1u); break; } } } } while (0)

struct XcdBarrier {
    unsigned* bar; unsigned x;
    volatile LAS unsigned* st;
};

__device__ __forceinline__ XcdBarrier xcd_barrier_post(unsigned* bar, volatile LAS unsigned* st) {
    XcdBarrier b; b.bar = bar; b.x = xb_xcc_id(); b.st = st;
    if (threadIdx.x == 0) (void)xb_add(&bar[XB_XCNT(b.x)], 1u);
    return b;
}
__device__ __forceinline__ void xcd_barrier_complete(unsigned* bar, unsigned x, unsigned& nloc, unsigned& nx) {
    const unsigned G = gridDim.x * gridDim.y * gridDim.z;
    unsigned sum, cnt, mine, sp = 0u;
    for (;;) {
        sum = 0u; cnt = 0u; mine = 0u;
#pragma unroll
        for (unsigned j = 0; j < 16; ++j) { const unsigned c = xb_ld(&bar[XB_XCNT(j)]); sum += c; cnt += (c > 0u) ? 1u : 0u; mine = (j == x) ? c : mine; }
        if (sum == G) break;
        __builtin_amdgcn_s_sleep(1);
        if ((++sp & 255u) == 0u) { if (xb_ld(&bar[XB_TMO])) break; if (sp > XB_SPIN_CAP) { atomicAdd(&bar[XB_TMO], 1u); break; } }
    }
    nloc = mine > 0u ? mine : 1u; nx = cnt > 0u ? cnt : 1u;
}

__device__ __forceinline__ void xcd_barrier(const XcdBarrier& b) {
    asm volatile("s_waitcnt vmcnt(0)" ::: "memory");
    __syncthreads();
    if (threadIdx.x == 0) {
        unsigned* bar = b.bar;
        __builtin_amdgcn_s_waitcnt(0);
        unsigned nloc = b.st[0], nx = b.st[1];
        if (nloc == 0u) { xcd_barrier_complete(bar, b.x, nloc, nx); b.st[0] = nloc; b.st[1] = nx; }
        const unsigned old = xb_add(&bar[XB_XSUB(b.x)], 1u);
        const unsigned gen = old / nloc;
        if (old + 1u == (gen + 1u) * nloc) {
            __builtin_amdgcn_fence(__ATOMIC_RELEASE, "agent");
            asm volatile("s_waitcnt vmcnt(0)" ::: "memory");
            const unsigned og = xb_add(&bar[XB_TOP], 1u);
            const unsigned tg = og / nx;
            if (og + 1u == (tg + 1u) * nx) xb_add(&bar[XB_TOPGEN], 1u);
            else XB_SPIN(xb_ld(&bar[XB_TOPGEN]) == tg, bar);
            __builtin_amdgcn_fence(__ATOMIC_ACQUIRE, "agent");
            xb_add(&bar[XB_XGEN(b.x)], 1u);
            asm volatile("s_waitcnt vmcnt(0)" ::: "memory");
        } else {
            XB_SPIN(xb_ld(&bar[XB_XGEN(b.x)]) == gen, bar);
            __builtin_amdgcn_fence(__ATOMIC_ACQUIRE, "agent");
            asm volatile("s_waitcnt vmcnt(0)" ::: "memory");
        }
    }
    __syncthreads();
}
#ifndef MK_SINGLE
#define MK_SINGLE 0
#endif
constexpr int NWAVES = 8;
constexpr int DM = 1024, MT = 12288, MC = 8192, DEPTH = 4, PIN = 3688, PINP = 3840, FFD = 4096;
constexpr int TC = 256, TL = 1024;
constexpr int C_RW_WD = 768, C_RW_AD = 800, C_RW_GD = 832, RWC = 864;
constexpr int C_HG_Q = 864, C_HG_I = 1120, C_HG_F = 1376, C_HG_G = 1888;
constexpr int C_SS_Z = 2144, C_SS_XBC = 2400, C_SS_DT = 3168;
constexpr int C_LR_Y = 3176, C_LR_X = 3432;
enum { I_XP = 0, I_XS, I_SRW, I_SHG, I_SSS, I_SLR, I_C, I_CCTX, I_MODW, I_MODB, I_NORMG, I_WIN, I_WOUT, I_RWMU, I_RWW0, I_RWW2, I_RWA0, I_RWA2, I_RWG2, I_RWKK, I_RWKA, I_RWRK,
       I_RWLNW, I_RWLNB, I_HGLB, I_HGNORM, I_SSCW, I_SSCB, I_SSDTB, I_SSALOG, I_SSD, I_SSNORM, I_LRCW, I_LRCB, I_LRWA, I_LRBA, I_LRWX, I_LRBX, I_LRLAM, I_W1, I_W2, N_IN };
constexpr size_t O_X = 0, O_SRW = 12582912, O_SHG = 16777216, O_SSS = 20971520, O_SLR = 29360128, O_END = 29425664;
constexpr size_t MiB = 1u << 20;
constexpr size_t WS_CTL = 0, CTL_ZERO_BYTES = 1 * MiB;
constexpr size_t WS_MOD = 1 * MiB;
constexpr size_t WS_LB = 1 * MiB + 512 * 1024;
constexpr size_t WS_WLR = 2 * MiB;
constexpr size_t WS_WIN = 3 * MiB;
constexpr size_t WS_WOUT = 33 * MiB;
constexpr size_t WS_W1 = 41 * MiB;
constexpr size_t WS_W2 = 73 * MiB;
constexpr size_t WS_PROJ = 105 * MiB;
constexpr size_t WS_MIX = 195 * MiB;
constexpr size_t WS_U = WS_PROJ;
constexpr size_t WS_H = 219 * MiB;
constexpr size_t WS_GO = 243 * MiB;
constexpr size_t A6 = 6 * MiB;
constexpr size_t WS_RW_R = 219 * MiB, WS_RW_KK = WS_RW_R + A6, WS_RW_V = WS_RW_KK + A6, WS_RW_KD = WS_RW_V + A6  , WS_RW_B = WS_RW_KD + 2 * A6  ,
                 WS_RW_G = WS_RW_B + 2 * A6, WS_RW_E = WS_RW_G + A6  , WS_RW_BON = WS_RW_E + 2 * A6  ;
constexpr size_t WS_SS_X = WS_RW_BON + 1 * MiB, WS_SS_B = WS_SS_X + A6, WS_SS_C = WS_SS_B + A6, WS_SS_DT = WS_SS_C + A6  , WS_SS_DEC = WS_SS_DT + 512 * 1024;
constexpr size_t WS_LR_LA = WS_SS_DT + 1 * MiB  , WS_LR_B = WS_LR_LA + 2 * A6;
constexpr size_t WS_YS = WS_LR_B + 2 * A6;
constexpr size_t WS_END = WS_YS + 8 * A6;
static_assert(WS_END == 371 * MiB, "ws map");
constexpr int CW_BAR = 4096;
constexpr int RING_BYTES = 131072, LDSCTL_OFF = RING_BYTES, MISC_OFF = LDSCTL_OFF + 320, LDS_BYTES = 147456;

typedef float f4 __attribute__((ext_vector_type(4)));
typedef float f2 __attribute__((ext_vector_type(2)));
__device__ __forceinline__ float bf2f(bf16 v) { return __uint_as_float((unsigned)v << 16); }
__device__ __forceinline__ float bflo(unsigned w) { return __uint_as_float(w << 16); }
__device__ __forceinline__ float bfhi(unsigned w) { return __uint_as_float(w & 0xffff0000u); }
__device__ __forceinline__ float sigmoidf_(float x) { return 1.f / (1.f + __expf(-x)); }
__device__ __forceinline__ float siluf_(float x) { return x / (1.f + __expf(-x)); }
__device__ __forceinline__ float softplusf_(float x) { return x > 20.f ? x : log1pf(__expf(x)); }
__device__ __forceinline__ float gelu_tanh(float x) { const float u = 0.7978845608028654f * (x + 0.044715f * x * x * x); return 0.5f * x * (1.f + tanhf(u)); }
__device__ __forceinline__ float wave_sum(float v) {
#pragma unroll
    for (int o = 1; o < 64; o <<= 1) v += __shfl_xor(v, o);
    return v;
}
template <int CTRL> __device__ __forceinline__ float dppf(float v) {
    return __builtin_bit_cast(float, __builtin_amdgcn_update_dpp(0, __builtin_bit_cast(int, v), CTRL, 0xF, 0xF, true));
}
__device__ __forceinline__ float sum16(float v) {
    v += dppf<0xB1>(v); v += dppf<0x4E>(v); v += dppf<0x141>(v); v += dppf<0x140>(v); return v;
}
__device__ __forceinline__ void cvt8(const v4u w, float (&o)[8]) {
    o[0] = bflo(w.x); o[1] = bfhi(w.x); o[2] = bflo(w.y); o[3] = bfhi(w.y); o[4] = bflo(w.z); o[5] = bfhi(w.z); o[6] = bflo(w.w); o[7] = bfhi(w.w);
}
__device__ __forceinline__ void st8(LAS float* p, const float (&o)[8]) { *(LAS f4*)p = (f4){o[0], o[1], o[2], o[3]}; *(LAS f4*)(p + 4) = (f4){o[4], o[5], o[6], o[7]}; }

struct Ctx {
    float* out; unsigned char* ws;
    int tid, lane, wave, G, wg;
    LAS unsigned char* lds;
};
constexpr int PTAB_OFF = 131584;
typedef const GAS float* gcf;
__device__ __forceinline__ gcf ldptr(const Ctx& C, int i) {
    const LAS unsigned* t = (const LAS unsigned*)(C.lds + PTAB_OFF) + 2 * i;
    const unsigned lo = __builtin_amdgcn_readfirstlane(t[0]), hi = __builtin_amdgcn_readfirstlane(t[1]);
    return (gcf)(((unsigned long long)hi << 32) | (unsigned long long)lo);
}
#define INP(i) ldptr(C, (i))
#define WSP(T, off) ((GAS T*)(C.ws + (off)))

__device__ __forceinline__ void tr_item(const float* W, int K, int N, int Np, bf16* WT, LAS float* scr, int item, int lane) {
    const int nblk = Np / 32, kb = item / nblk, nb = item % nblk, k0 = 64 * kb, n0 = 32 * nb;
    const int nn = n0 + (lane & 31); const bool ok = nn < N;
#pragma unroll 8
    for (int i = 0; i < 32; ++i) { const int kk = 2 * i + (lane >> 5); scr[kk * 33 + (lane & 31)] = ok ? W[(size_t)(k0 + kk) * N + nn] : 0.f; }
    LDS_WAIT(); asm volatile("" ::: "memory");
    const int c = lane & 7;
#pragma unroll
    for (int j = 0; j < 4; ++j) { const int n = (lane >> 3) + 8 * j; const LAS float* s = scr + (8 * c) * 33 + n;
        v4u o; o.x = pk2(s[0 * 33], s[1 * 33]); o.y = pk2(s[2 * 33], s[3 * 33]); o.z = pk2(s[4 * 33], s[5 * 33]); o.w = pk2(s[6 * 33], s[7 * 33]);
        *(GAS v4u*)(WT + (size_t)(n0 + n) * K + k0 + 8 * c) = o; }
    LDS_WAIT(); asm volatile("" ::: "memory");
}
__device__ __forceinline__ void p0_prologue(const Ctx& C) {
    const int gw = C.wg * NWAVES + C.wave, NGW = C.G * NWAVES;
    {
        LAS float* scr = (LAS float*)(C.lds + C.wave * 16384);
        constexpr int I_IN = 16 * (PINP / 32), I_OUT = 16 * 32, I_1 = 16 * (FFD / 32), I_2 = 64 * 32, I_L = I_IN + I_OUT + I_1 + I_2;
        for (int it = gw; it < DEPTH * I_L; it += NGW) {
            const int l = it / I_L; int r = it - l * I_L;
            if (r < I_IN) { tr_item(INP(I_WIN) + (size_t)l * DM * PIN, DM, PIN, PINP, WSP(bf16, WS_WIN) + (size_t)l * PINP * DM, scr, r, C.lane); continue; } r -= I_IN;
            if (r < I_OUT) { tr_item(INP(I_WOUT) + (size_t)l * DM * DM, DM, DM, DM, WSP(bf16, WS_WOUT) + (size_t)l * DM * DM, scr, r, C.lane); continue; } r -= I_OUT;
            if (r < I_1) { tr_item(INP(I_W1) + (size_t)l * DM * FFD, DM, FFD, FFD, WSP(bf16, WS_W1) + (size_t)l * FFD * DM, scr, r, C.lane); continue; } r -= I_1;
            tr_item(INP(I_W2) + (size_t)l * FFD * DM, FFD, DM, DM, WSP(bf16, WS_W2) + (size_t)l * DM * FFD, scr, r, C.lane);
        }
    }
    {
        bf16* WLR = WSP(bf16, WS_WLR);
        for (int o = C.wg * 512 + C.tid; o < DEPTH * 2 * 2 * 4 * 64 * 64; o += C.G * 512) {
            const int i = o & 63, j = (o >> 6) & 63, h = (o >> 12) & 3, g = (o >> 14) & 1, d = (o >> 15) & 1, l = o >> 16;
            const float* src = g ? INP(I_LRWX) : INP(I_LRWA);
            WLR[o] = (bf16)f2bf(src[((((size_t)l * 2 + d) * 4 + h) * 64 + i) * 64 + j]);
        }
    }
    {
        float* LB = WSP(float, WS_LB);
        for (int o = C.wg * 512 + C.tid; o < 512; o += C.G * 512) {
            float v[4], mx = -1e30f;
#pragma unroll
            for (int l = 0; l < 4; ++l) { v[l] = INP(I_HGLB)[l * 512 + o]; mx = fmaxf(mx, v[l]); }
            float s = 0.f;
#pragma unroll
            for (int l = 0; l < 4; ++l) { v[l] = expf(v[l] - mx); s += v[l]; }
            const float inv = 1.f / s; float cum = 0.f;
#pragma unroll
            for (int l = 0; l < 4; ++l) { const float p = v[l] * inv; cum += p; LB[l * 512 + o] = cum - v[0] * inv; }
        }
    }
    __syncthreads();
    {
        LAS float* SC = (LAS float*)C.lds;
        LAS float* RED = SC + 5 * 1024;
        bool staged = false;
        for (int u = C.wg; u < DEPTH * 48; u += C.G) {
            if (!staged) {
                for (int e = C.tid; e < 5 * 1024; e += 512) { const int cnd = e >> 10, k = e & 1023; const float x = cnd == 0 ? INP(I_CCTX)[k] : INP(I_C)[(cnd - 1) * 1024 + k]; SC[e] = siluf_(x); }
                staged = true;
            }
            __syncthreads();
            const int l = u / 48, j0 = (u % 48) * 128 + 2 * C.lane;
            const float* wp = INP(I_MODW) + (size_t)l * DM * 6144 + j0;
            float acc[5][2];
#pragma unroll
            for (int cnd = 0; cnd < 5; ++cnd) { acc[cnd][0] = 0.f; acc[cnd][1] = 0.f; }
            const int kb = C.wave * 128;
#pragma unroll 8
            for (int k = kb; k < kb + 128; ++k) { const f2 w = *(const f2*)(wp + (size_t)k * 6144);
#pragma unroll
                for (int cnd = 0; cnd < 5; ++cnd) { const float s = SC[cnd * 1024 + k]; acc[cnd][0] += s * w.x; acc[cnd][1] += s * w.y; } }
#pragma unroll
            for (int cnd = 0; cnd < 5; ++cnd) { RED[(C.wave * 5 + cnd) * 128 + 2 * C.lane] = acc[cnd][0]; RED[(C.wave * 5 + cnd) * 128 + 2 * C.lane + 1] = acc[cnd][1]; }
            __syncthreads();
            for (int e = C.tid; e < 5 * 128; e += 512) { const int cnd = e >> 7, j = e & 127; float s = 0.f;
#pragma unroll
                for (int w = 0; w < 8; ++w) s += RED[(w * 5 + cnd) * 128 + j];
                const int col = (u % 48) * 128 + j;
                WSP(float, WS_MOD)[((size_t)l * 5 + cnd) * 6144 + col] = s + INP(I_MODB)[l * 6144 + col]; }
        }
        __syncthreads();
    }
}

__device__ __forceinline__ const float* mod_row(const Ctx& C, int l, int m) { const int cnd = m < MC ? 0 : 1 + ((m - MC) >> 10); return WSP(const float, WS_MOD) + ((size_t)l * 5 + cnd) * 6144; }
__device__ __forceinline__ void write_h(const Ctx& C, const f4 (&x)[4], float ssq, const float* g, const float* sc, const float* sh, bf16* hrow) {
    const float rs = rsqrtf(ssq * (1.f / DM) + 1e-6f);
#pragma unroll
    for (int j = 0; j < 4; ++j) { const int c = 4 * C.lane + 256 * j; const f4 gg = *(const f4*)(g + c), s1 = *(const f4*)(sc + c), s0 = *(const f4*)(sh + c);
        const f4 y = x[j] * rs * gg * (1.f + s1) + s0;
        *(GAS unsigned long long*)(hrow + c) = (unsigned long long)pk2(y.x, y.y) | ((unsigned long long)pk2(y.z, y.w) << 32); }
}
__device__ __forceinline__ void phase_norm_in(const Ctx& C) {
    const int gw = C.wg * NWAVES + C.wave, NGW = C.G * NWAVES;
    const float* ng = INP(I_NORMG);
    for (int m = gw; m < MT; m += NGW) {
        const float* xr = m < MC ? INP(I_XP) + (size_t)m * DM : INP(I_XS) + (size_t)(m - MC) * DM;
        float* xo = C.out + O_X + (size_t)m * DM;
        f4 x[4]; float ss = 0.f;
#pragma unroll
        for (int j = 0; j < 4; ++j) { x[j] = *(const f4*)(xr + 4 * C.lane + 256 * j); *(f4*)(xo + 4 * C.lane + 256 * j) = x[j]; ss += (x[j].x * x[j].x + x[j].y * x[j].y) + (x[j].z * x[j].z + x[j].w * x[j].w); }
        ss = wave_sum(ss);
        const float* md = mod_row(C, 0, m);
        write_h(C, x, ss, ng + 0 * DM, md + 1 * DM, md + 0 * DM, WSP(bf16, WS_H) + (size_t)m * DM);
    }
}
__device__ __forceinline__ void phase_norm_res(const Ctx& C, int l, int which) {
    const int gw = C.wg * NWAVES + C.wave, NGW = C.G * NWAVES;
    const float* ng = INP(I_NORMG);
    const float* gpost = ng + ((size_t)l * 4 + (which ? 3 : 1)) * DM;
    const bool wh = which == 0 || l + 1 < DEPTH;
    const int ln = which ? l + 1 : l;
    const float* gpre = ng + ((size_t)ln * 4 + (which ? 0 : 2)) * DM;
    const float* GO = WSP(const float, WS_GO);
    for (int m = gw; m < MT; m += NGW) {
        const float* gr = GO + (size_t)m * DM; float* xo = C.out + O_X + (size_t)m * DM;
        const float* md = mod_row(C, l, m);
        const float* gate = md + (which ? 5 : 2) * DM;
        f4 go[4], x[4]; float ss = 0.f;
#pragma unroll
        for (int j = 0; j < 4; ++j) { go[j] = *(const f4*)(gr + 4 * C.lane + 256 * j); x[j] = *(const f4*)(xo + 4 * C.lane + 256 * j); ss += (go[j].x * go[j].x + go[j].y * go[j].y) + (go[j].z * go[j].z + go[j].w * go[j].w); }
        ss = wave_sum(ss);
        const float rs = rsqrtf(ss * (1.f / DM) + 1e-6f); float s2 = 0.f;
#pragma unroll
        for (int j = 0; j < 4; ++j) { const int c = 4 * C.lane + 256 * j; const f4 gp = *(const f4*)(gpost + c), gt = *(const f4*)(gate + c);
            x[j] = x[j] + gt * (go[j] * rs * gp); *(f4*)(xo + c) = x[j]; s2 += (x[j].x * x[j].x + x[j].y * x[j].y) + (x[j].z * x[j].z + x[j].w * x[j].w); }
        if (wh) {
            s2 = wave_sum(s2);
            const float* md2 = mod_row(C, ln, m);
            write_h(C, x, s2, gpre, md2 + (which ? 1 : 4) * DM, md2 + (which ? 0 : 3) * DM, WSP(bf16, WS_H) + (size_t)m * DM);
        }
    }
}

__device__ __forceinline__ void conv16(const bf16* col, int t0, int T, const float (&w)[4], float bias, float (&y)[16]) {
    float x[19];
#pragma unroll
    for (int i = 0; i < 19; ++i) { const int t = t0 - 2 + i; x[i] = (t >= 0 && t < T) ? bf2f(col[(size_t)t * PINP]) : 0.f; }
#pragma unroll
    for (int j = 0; j < 16; ++j) y[j] = bias + w[0] * x[j] + w[1] * x[j + 1] + w[2] * x[j + 2] + w[3] * x[j + 3];
}
__device__ __forceinline__ void prep_tile(const Ctx& C, int l, int tile) {
    const int tid = C.tid, lane = C.lane;
    const int m0 = tile * 16; const bool lat = m0 >= MC; const int T = lat ? TL : TC;
    const int ms = lat ? MC + (((m0 - MC) >> 10) << 10) : (m0 & ~255); const int t0 = m0 - ms;
    const bf16* PROJ = WSP(const bf16, WS_PROJ);
    LAS float* XM = (LAS float*)C.lds;
    LAS float* TW = XM + 16 * RWC;
    LAS float* SG = TW + 512;
    LAS float* XCf = SG + 512;
    LAS bf16* XCb = (LAS bf16*)(XCf + 4096);
#ifndef PREP_EN
#define PREP_EN 0xFF
#endif
    const float* mu = INP(I_RWMU) + l * RWC;
    for (int idx = tid; idx < 16 * RWC; idx += 512) {
        const int j = idx / RWC, c = idx - j * RWC, t = t0 + j, m = m0 + j;
        const float p = bf2f(PROJ[(size_t)m * PINP + c]);
        bool ok; int src;
        if (!lat) { if (c < 432) { ok = t >= 1; src = m - 1; } else { ok = t <= T - 2; src = m + 1; } }
        else { const int gc = t & 63, gr = t >> 6;
            if (c < 216) { ok = gc > 0; src = m - 1; } else if (c < 432) { ok = gc < 63; src = m + 1; } else if (c < 648) { ok = gr > 0; src = m - 64; } else { ok = gr < 15; src = m + 64; } }
        const float s = ok ? bf2f(PROJ[(size_t)src * PINP + c]) : 0.f;
        XM[idx] = p + (s - p) * mu[c];
    }
    __syncthreads();
    { const int j = tid >> 5, e = tid & 31; TW[tid] = tanhf(XM[j * RWC + C_RW_WD + e]); SG[tid] = sigmoidf_(XM[j * RWC + C_RW_GD + e]); }
    __syncthreads();
    if (PREP_EN & 1) {
        int c = tid & 255; asm volatile("" : "+v"(c));
        const int half = tid >> 8, h = c >> 6;
        bf16* oR = WSP(bf16, WS_RW_R); bf16* oKK = WSP(bf16, WS_RW_KK); bf16* oV = WSP(bf16, WS_RW_V); bf16* oKD = WSP(bf16, WS_RW_KD); bf16* oB = WSP(bf16, WS_RW_B);
        bf16* oG = WSP(bf16, WS_RW_G); bf16* oE = WSP(bf16, WS_RW_E); float* oBON = WSP(float, WS_RW_BON);
        {
            float w2r[2][16], a2r[2][16];
#pragma unroll
            for (int d = 0; d < 2; ++d)
#pragma unroll
                for (int jj = 0; jj < 16; ++jj) { w2r[d][jj] = INP(I_RWW2)[(((size_t)l * 2 + d) * 16 + jj) * 256 + c]; a2r[d][jj] = INP(I_RWA2)[(((size_t)l * 2 + d) * 16 + jj) * 256 + c]; }
            const float w0_0 = INP(I_RWW0)[(l * 2 + 0) * 256 + c], w0_1 = INP(I_RWW0)[(l * 2 + 1) * 256 + c];
            const float a0_0 = INP(I_RWA0)[(l * 2 + 0) * 256 + c], a0_1 = INP(I_RWA0)[(l * 2 + 1) * 256 + c];
            const float kkw = INP(I_RWKK)[l * 256 + c], ka = INP(I_RWKA)[l * 256 + c], rk = INP(I_RWRK)[l * 256 + c];
#pragma unroll 1
            for (int jt = 0; jt < 8; ++jt) {
                const int j = half * 8 + jt; const size_t m = (size_t)(m0 + j);
                const float r = XM[j * RWC + c], k = XM[j * RWC + 256 + c], v = XM[j * RWC + 512 + c];
                const float kkr = k * kkw; const float ssq = wave_sum(kkr * kkr); const float kkn = kkr / fmaxf(sqrtf(ssq), 1e-12f);
                float lw0 = 0.f, lw1 = 0.f, la0 = 0.f, la1 = 0.f;
#pragma unroll
                for (int jj = 0; jj < 16; ++jj) { lw0 += TW[j * 32 + jj] * w2r[0][jj]; lw1 += TW[j * 32 + 16 + jj] * w2r[1][jj];
                    la0 += XM[j * RWC + C_RW_AD + jj] * a2r[0][jj]; la1 += XM[j * RWC + C_RW_AD + 16 + jj] * a2r[1][jj]; }
                const float e0 = 0.6065306597126334f * sigmoidf_(w0_0 + lw0), e1 = 0.6065306597126334f * sigmoidf_(w0_1 + lw1);
                const float a0 = sigmoidf_(a0_0 + la0), a1 = sigmoidf_(a0_1 + la1);
                const float kd0 = k * (1.f + (a0 - 1.f) * ka), kd1 = k * (1.f + (a1 - 1.f) * ka);
                const float bon = wave_sum(r * (kd0 + kd1) * rk);
                if (lane == 0) oBON[m * 4 + h] = bon;
                const size_t o = m * 256 + c, o1 = ((size_t)MT + m) * 256 + c;
                oR[o] = (bf16)f2bf(r); oKK[o] = (bf16)f2bf(kkn); oV[o] = (bf16)f2bf(v);
                oKD[o] = (bf16)f2bf(kd0); oKD[o1] = (bf16)f2bf(kd1); oB[o] = (bf16)f2bf(kkn * a0); oB[o1] = (bf16)f2bf(kkn * a1);
                oE[o] = (bf16)f2bf(e0); oE[o1] = (bf16)f2bf(e1);
            }
        }
        {
            float g2r[32];
#pragma unroll
            for (int jj = 0; jj < 32; ++jj) g2r[jj] = INP(I_RWG2)[((size_t)l * 32 + jj) * 256 + c];
#pragma unroll 1
            for (int jt = 0; jt < 8; ++jt) {
                const int j = half * 8 + jt; float g = 0.f;
#pragma unroll
                for (int jj = 0; jj < 32; ++jj) g += SG[j * 32 + jj] * g2r[jj];
                oG[(size_t)(m0 + j) * 256 + c] = (bf16)f2bf(g);
            }
        }
    }
    if (PREP_EN & 2) {
        const bf16* base = PROJ + (size_t)ms * PINP + C_SS_XBC;
#pragma unroll 1
        for (int rep = 0; rep < 2; ++rep) {
            const int c = tid + 512 * rep; if (c >= 768) break;
            float w[4], y[16];
#pragma unroll
            for (int j = 0; j < 4; ++j) w[j] = INP(I_SSCW)[((size_t)l * 4 + j) * 768 + c];
            conv16(base + c, t0, T, w, INP(I_SSCB)[l * 768 + c], y);
            bf16* dst = (c < 256 ? WSP(bf16, WS_SS_X) : (c < 512 ? WSP(bf16, WS_SS_B) : WSP(bf16, WS_SS_C))) + (c & 255);
#pragma unroll
            for (int j = 0; j < 16; ++j) dst[(size_t)(m0 + j) * 256] = (bf16)f2bf(siluf_(y[j]));
        }
        if (tid < 128) {
            const int j = tid >> 3, d = (tid >> 2) & 1, h = tid & 3; const size_t m = (size_t)(m0 + j);
            const float dtr = bf2f(PROJ[m * PINP + C_SS_DT + d * 4 + h]);
            const float dt = softplusf_(dtr + INP(I_SSDTB)[(l * 2 + d) * 4 + h]);
            const float an = -expf(INP(I_SSALOG)[(l * 2 + d) * 4 + h]);
            WSP(float, WS_SS_DT)[((size_t)d * MT + m) * 4 + h] = dt; WSP(float, WS_SS_DEC)[((size_t)d * MT + m) * 4 + h] = expf(dt * an);
        }
    }
    if ((PREP_EN & 4) && tid < 256) {
        const int c = tid; float w[4], y[16];
#pragma unroll
        for (int j = 0; j < 4; ++j) w[j] = INP(I_LRCW)[((size_t)l * 4 + j) * 256 + c];
        conv16(PROJ + (size_t)ms * PINP + C_LR_X + c, t0, T, w, INP(I_LRCB)[l * 256 + c], y);
#pragma unroll
        for (int j = 0; j < 16; ++j) { XCf[j * 256 + c] = y[j]; XCb[j * 264 + c] = (bf16)f2bf(y[j]); }
    }
    __syncthreads();
    if (PREP_EN & 8) {
        const int d = C.wave >> 2, h = C.wave & 3, fr = lane & 15, fq = lane >> 4;
        f32x4 acc[2][4];
#pragma unroll
        for (int g = 0; g < 2; ++g)
#pragma unroll
            for (int nt = 0; nt < 4; ++nt) acc[g][nt] = (f32x4){0.f, 0.f, 0.f, 0.f};
        const bf16* WLR = WSP(const bf16, WS_WLR);
#pragma unroll
        for (int ks = 0; ks < 2; ++ks) {
            const bf16x8 A = *(const LAS bf16x8*)(XCb + fr * 264 + h * 64 + ks * 32 + 8 * fq);
#pragma unroll
            for (int g = 0; g < 2; ++g)
#pragma unroll
                for (int nt = 0; nt < 4; ++nt) {
                    const bf16x8 B = *(const bf16x8*)(WLR + ((((size_t)(l * 2 + d) * 2 + g) * 4 + h) * 64 + nt * 16 + fr) * 64 + ks * 32 + 8 * fq);
                    acc[g][nt] = __builtin_amdgcn_mfma_f32_16x16x32_bf16(A, B, acc[g][nt], 0, 0, 0);
                }
        }
        bf16* oLA = WSP(bf16, WS_LR_LA); bf16* oLB = WSP(bf16, WS_LR_B);
#pragma unroll
        for (int nt = 0; nt < 4; ++nt) {
            const int c = h * 64 + nt * 16 + fr;
            const float ba = INP(I_LRBA)[(l * 2 + d) * 256 + c], bx = INP(I_LRBX)[(l * 2 + d) * 256 + c];
            const float sp = softplusf_(-INP(I_LRLAM)[(l * 2 + d) * 256 + c]);
#pragma unroll
            for (int rg = 0; rg < 4; ++rg) {
                const int j = fq * 4 + rg;
                const float r = sigmoidf_(acc[0][nt][rg] + ba), ig = sigmoidf_(acc[1][nt][rg] + bx);
                const float la = -8.f * r * sp;
                const float bq = sqrtf(fmaxf(-expm1f(2.f * la), 0.f)) * (ig * XCf[j * 256 + c]);
                const size_t o = ((size_t)d * MT + m0 + j) * 256 + c;
                oLA[o] = (bf16)f2bf(la); oLB[o] = (bf16)f2bf(bq);
            }
        }
    }
    __syncthreads();
}

constexpr int SC_Y = 49152;
__device__ __forceinline__ v4u ld16(const bf16* p) { return *(const GAS v4u*)p; }
#define STEP_TOKEN(cc, s) (d ? (T - 1 - ((cc) * 32 + (s))) : ((cc) * 32 + (s)))

__device__ __forceinline__ void flush_y(const Ctx& C, bf16* ydst  , int cc, int d, int T) {
    const LAS float* Y = (const LAS float*)(C.lds + SC_Y);
    const int s = C.tid >> 4, pr = C.tid & 15; const int t = STEP_TOKEN(cc, s);
    *(GAS unsigned*)(ydst + (size_t)t * 256 + 2 * pr) = pk2(Y[s * 32 + 2 * pr], Y[s * 32 + 2 * pr + 1]);
}

__device__ __forceinline__ void scan_rwkv(const Ctx& C, int l, int lat, int b, int d, int h, int rb) {
    const int tid = C.tid, row = tid >> 4, q = tid & 15;
    const int T = lat ? TL : TC, ms = lat ? MC + b * TL : b * TC, nch = T / 32;
    LAS float* LW = (LAS float*)C.lds; LAS float* LKK = LW + 2048; LAS float* LB_ = LW + 4096; LAS float* LKD = LW + 6144; LAS float* LR = LW + 8192; LAS float* LV = LW + 10240; LAS float* LY = (LAS float*)(C.lds + SC_Y);
    const int hi = tid >> 8, p = tid & 255, ps = p >> 3, pp = p & 7;
    const size_t doff = (size_t)d * MT * 256;
    const bf16* a0 = (hi ? WSP(const bf16, WS_RW_KK) : WSP(const bf16, WS_RW_E) + doff) + (size_t)ms * 256 + h * 64 + pp * 8;
    const bf16* a1 = (hi ? WSP(const bf16, WS_RW_KD) + doff : WSP(const bf16, WS_RW_B) + doff) + (size_t)ms * 256 + h * 64 + pp * 8;
    const bf16* a2 = hi ? WSP(const bf16, WS_RW_V) + (size_t)ms * 256 + h * 64 + rb * 32 + (p & 3) * 8 : WSP(const bf16, WS_RW_R) + (size_t)ms * 256 + h * 64 + pp * 8;
    const int s2 = hi ? (p >> 2) : ps; const bool do2 = !hi || p < 128;
    LAS float* d0 = (hi ? LKK : LW) + ps * 64 + pp * 8; LAS float* d1 = (hi ? LKD : LB_) + ps * 64 + pp * 8; LAS float* d2 = hi ? LV + (p >> 2) * 32 + (p & 3) * 8 : LR + ps * 64 + pp * 8;
    float S0, S1, S2, S3;
    const int v = rb * 32 + row;
    if (lat) { const f4 s = *(const f4*)(INP(I_SRW) + ((((size_t)(b * 4 + l) * 2 + d) * 4 + h) * 64 + v) * 64 + 4 * q); S0 = s.x; S1 = s.y; S2 = s.z; S3 = s.w; }
    else { S0 = S1 = S2 = S3 = 0.f; }
    bf16* ydst = WSP(bf16, WS_YS) + ((size_t)(0 * 2 + d) * MT + ms) * 256 + h * 64 + rb * 32;
    v4u pf0, pf1, pf2 = (v4u){0u, 0u, 0u, 0u};
    { pf0 = ld16(a0 + (size_t)STEP_TOKEN(0, ps) * 256); pf1 = ld16(a1 + (size_t)STEP_TOKEN(0, ps) * 256); if (do2) pf2 = ld16(a2 + (size_t)STEP_TOKEN(0, s2) * 256); }
#pragma unroll 1
    for (int cc = 0; cc < nch; ++cc) {
        { float o[8]; cvt8(pf0, o); if (!hi) {
#pragma unroll
                for (int i = 0; i < 8; ++i) o[i] = __expf(-o[i]); }
            st8(d0, o); cvt8(pf1, o); st8(d1, o); if (do2) { cvt8(pf2, o); st8(d2, o); } }
        __syncthreads();
        if (cc + 1 < nch) { pf0 = ld16(a0 + (size_t)STEP_TOKEN(cc + 1, ps) * 256); pf1 = ld16(a1 + (size_t)STEP_TOKEN(cc + 1, ps) * 256); if (do2) pf2 = ld16(a2 + (size_t)STEP_TOKEN(cc + 1, s2) * 256); }
#pragma unroll 4
        for (int s = 0; s < 32; ++s) {
            const f4 w = *(const LAS f4*)(LW + s * 64 + 4 * q), kk = *(const LAS f4*)(LKK + s * 64 + 4 * q), bv = *(const LAS f4*)(LB_ + s * 64 + 4 * q),
                     kd = *(const LAS f4*)(LKD + s * 64 + 4 * q), r = *(const LAS f4*)(LR + s * 64 + 4 * q);
            const float vv = LV[s * 32 + row];
            const float sa = -sum16((S0 * kk.x + S1 * kk.y) + (S2 * kk.z + S3 * kk.w));
            S0 = S0 * w.x + (sa * bv.x + vv * kd.x); S1 = S1 * w.y + (sa * bv.y + vv * kd.y); S2 = S2 * w.z + (sa * bv.z + vv * kd.z); S3 = S3 * w.w + (sa * bv.w + vv * kd.w);
            const float yp = sum16((S0 * r.x + S1 * r.y) + (S2 * r.z + S3 * r.w));
            if (q == 0) LY[s * 32 + row] = yp;
        }
        __syncthreads();
        flush_y(C, ydst, cc, d, T);
    }
    if (!lat) *(f4*)(C.out + O_SRW + ((((size_t)(b * 4 + l) * 2 + d) * 4 + h) * 64 + v) * 64 + 4 * q) = (f4){S0, S1, S2, S3};
}

__device__ __forceinline__ void scan_hgrn(const Ctx& C, int l, int lat, int b, int d, int h, int vb) {
    const int tid = C.tid, row = tid >> 4, q = tid & 15;
    const int T = lat ? TL : TC, ms = lat ? MC + b * TL : b * TC, nch = T / 32;
    LAS float* LQ = (LAS float*)C.lds; LAS float* LF = LQ + 2048; LAS float* LKD = LQ + 4096; LAS float* LI = LQ + 6144; LAS float* LY = (LAS float*)(C.lds + SC_Y);
    const int hi = tid >> 8, p = tid & 255, ps = p >> 3, pp = p & 7;
    const bf16* PROJ = WSP(const bf16, WS_PROJ);
    const bf16* a0 = PROJ + (size_t)ms * PINP + (hi ? C_HG_F + d * 256 : C_HG_Q) + h * 64 + pp * 8;
    const bf16* a2 = PROJ + (size_t)ms * PINP + C_HG_I + h * 64 + vb * 32 + (p & 3) * 8;
    const bool do2 = !hi && p < 128; const int s2 = p >> 2;
    float lb[8];
#pragma unroll
    for (int i = 0; i < 8; ++i) lb[i] = WSP(const float, WS_LB)[(l * 2 + d) * 256 + h * 64 + pp * 8 + i];
    const int v = vb * 32 + row;
    float S0, S1, S2, S3;
    if (lat) { const float* sp = INP(I_SHG) + ((((size_t)(b * 4 + l) * 2 + d) * 4 + h) * 64 + 4 * q) * 64 + v; S0 = sp[0]; S1 = sp[64]; S2 = sp[128]; S3 = sp[192]; }
    else { S0 = S1 = S2 = S3 = 0.f; }
    bf16* ydst = WSP(bf16, WS_YS) + ((size_t)(1 * 2 + d) * MT + ms) * 256 + h * 64 + vb * 32;
    v4u pf0, pf2 = (v4u){0u, 0u, 0u, 0u};
    { pf0 = ld16(a0 + (size_t)STEP_TOKEN(0, ps) * PINP); if (do2) pf2 = ld16(a2 + (size_t)STEP_TOKEN(0, s2) * PINP); }
#pragma unroll 1
    for (int cc = 0; cc < nch; ++cc) {
        { float o[8]; cvt8(pf0, o);
            if (!hi) {
#pragma unroll
                for (int i = 0; i < 8; ++i) o[i] = siluf_(o[i]);
                st8(LQ + ps * 64 + pp * 8, o);
            } else { float kd[8];
#pragma unroll
                for (int i = 0; i < 8; ++i) { const float sg = sigmoidf_(o[i]); kd[i] = (1.f - lb[i]) * (1.f - sg); o[i] = lb[i] + (1.f - lb[i]) * sg; }
                st8(LF + ps * 64 + pp * 8, o); st8(LKD + ps * 64 + pp * 8, kd); }
            if (do2) { cvt8(pf2, o); st8(LI + s2 * 32 + (p & 3) * 8, o); } }
        __syncthreads();
        if (cc + 1 < nch) { pf0 = ld16(a0 + (size_t)STEP_TOKEN(cc + 1, ps) * PINP); if (do2) pf2 = ld16(a2 + (size_t)STEP_TOKEN(cc + 1, s2) * PINP); }
#pragma unroll 4
        for (int s = 0; s < 32; ++s) {
            const f4 f = *(const LAS f4*)(LF + s * 64 + 4 * q), kd = *(const LAS f4*)(LKD + s * 64 + 4 * q), qq = *(const LAS f4*)(LQ + s * 64 + 4 * q);
            const float iv = LI[s * 32 + row];
            S0 = f.x * S0 + kd.x * iv; S1 = f.y * S1 + kd.y * iv; S2 = f.z * S2 + kd.z * iv; S3 = f.w * S3 + kd.w * iv;
            const float o = sum16((S0 * qq.x + S1 * qq.y) + (S2 * qq.z + S3 * qq.w));
            if (q == 0) LY[s * 32 + row] = o;
        }
        __syncthreads();
        flush_y(C, ydst, cc, d, T);
    }
    if (!lat) { float* sp = C.out + O_SHG + ((((size_t)(b * 4 + l) * 2 + d) * 4 + h) * 64 + 4 * q) * 64 + v; sp[0] = S0; sp[64] = S1; sp[128] = S2; sp[192] = S3; }
}

__device__ __forceinline__ void scan_ssd(const Ctx& C, int l, int lat, int b, int d, int h, int pb) {
    const int tid = C.tid, row = tid >> 4, q = tid & 15;
    const int T = lat ? TL : TC, ms = lat ? MC + b * TL : b * TC, nch = T / 32;
    LAS float* LBm = (LAS float*)C.lds; LAS float* LCm = LBm + 4096; LAS float* LX = LBm + 8192; LAS float* LDT = LBm + 9216; LAS float* LDEC = LBm + 9248; LAS float* LY = (LAS float*)(C.lds + SC_Y);
    const int ps = tid >> 4, pp = tid & 15, g = h >> 1;
    const bf16* aB = WSP(const bf16, WS_SS_B) + (size_t)ms * 256 + g * 128 + pp * 8;
    const bf16* aC = WSP(const bf16, WS_SS_C) + (size_t)ms * 256 + g * 128 + pp * 8;
    const bf16* aX = WSP(const bf16, WS_SS_X) + (size_t)ms * 256 + h * 64 + pb * 32 + (tid & 3) * 8;
    const float* aDT = WSP(const float, WS_SS_DT) + ((size_t)d * MT + ms) * 4 + h; const float* aDEC = WSP(const float, WS_SS_DEC) + ((size_t)d * MT + ms) * 4 + h;
    const bool doX = tid < 128, doD = tid >= 128 && tid < 160; const int sX = tid >> 2, sD = tid - 128;
    const int pr = pb * 32 + row;
    float S[8];
    if (lat) { const float* sp = INP(I_SSS) + ((((size_t)(b * 4 + l) * 2 + d) * 4 + h) * 64 + pr) * 128 + 8 * q; const f4 x = *(const f4*)sp, y = *(const f4*)(sp + 4); S[0] = x.x; S[1] = x.y; S[2] = x.z; S[3] = x.w; S[4] = y.x; S[5] = y.y; S[6] = y.z; S[7] = y.w; }
    else {
#pragma unroll
        for (int i = 0; i < 8; ++i) S[i] = 0.f; }
    bf16* ydst = WSP(bf16, WS_YS) + ((size_t)(2 * 2 + d) * MT + ms) * 256 + h * 64 + pb * 32;
    v4u pfB, pfC, pfX = (v4u){0u, 0u, 0u, 0u}; float pfDT = 0.f, pfDEC = 0.f;
    { pfB = ld16(aB + (size_t)STEP_TOKEN(0, ps) * 256); pfC = ld16(aC + (size_t)STEP_TOKEN(0, ps) * 256); if (doX) pfX = ld16(aX + (size_t)STEP_TOKEN(0, sX) * 256);
      if (doD) { pfDT = aDT[(size_t)STEP_TOKEN(0, sD) * 4]; pfDEC = aDEC[(size_t)STEP_TOKEN(0, sD) * 4]; } }
#pragma unroll 1
    for (int cc = 0; cc < nch; ++cc) {
        { float o[8]; cvt8(pfB, o); st8(LBm + ps * 128 + pp * 8, o); cvt8(pfC, o); st8(LCm + ps * 128 + pp * 8, o);
          if (doX) { cvt8(pfX, o); st8(LX + sX * 32 + (tid & 3) * 8, o); }
          if (doD) { LDT[sD] = pfDT; LDEC[sD] = pfDEC; } }
        __syncthreads();
        if (cc + 1 < nch) { pfB = ld16(aB + (size_t)STEP_TOKEN(cc + 1, ps) * 256); pfC = ld16(aC + (size_t)STEP_TOKEN(cc + 1, ps) * 256); if (doX) pfX = ld16(aX + (size_t)STEP_TOKEN(cc + 1, sX) * 256);
            if (doD) { pfDT = aDT[(size_t)STEP_TOKEN(cc + 1, sD) * 4]; pfDEC = aDEC[(size_t)STEP_TOKEN(cc + 1, sD) * 4]; } }
#pragma unroll 2
        for (int s = 0; s < 32; ++s) {
            const f4 b0 = *(const LAS f4*)(LBm + s * 128 + 8 * q), b1 = *(const LAS f4*)(LBm + s * 128 + 8 * q + 4), c0 = *(const LAS f4*)(LCm + s * 128 + 8 * q), c1 = *(const LAS f4*)(LCm + s * 128 + 8 * q + 4);
            const float xdt = LX[s * 32 + row] * LDT[s], dec = LDEC[s];
            S[0] = dec * S[0] + xdt * b0.x; S[1] = dec * S[1] + xdt * b0.y; S[2] = dec * S[2] + xdt * b0.z; S[3] = dec * S[3] + xdt * b0.w;
            S[4] = dec * S[4] + xdt * b1.x; S[5] = dec * S[5] + xdt * b1.y; S[6] = dec * S[6] + xdt * b1.z; S[7] = dec * S[7] + xdt * b1.w;
            const float y = sum16(((S[0] * c0.x + S[1] * c0.y) + (S[2] * c0.z + S[3] * c0.w)) + ((S[4] * c1.x + S[5] * c1.y) + (S[6] * c1.z + S[7] * c1.w)));
            if (q == 0) LY[s * 32 + row] = y;
        }
        __syncthreads();
        flush_y(C, ydst, cc, d, T);
    }
    if (!lat) { float* sp = C.out + O_SSS + ((((size_t)(b * 4 + l) * 2 + d) * 4 + h) * 64 + pr) * 128 + 8 * q; *(f4*)sp = (f4){S[0], S[1], S[2], S[3]}; *(f4*)(sp + 4) = (f4){S[4], S[5], S[6], S[7]}; }
}

__device__ __forceinline__ void scan_lru(const Ctx& C, int l, int lat, int b) {
    const int d = C.tid >> 8, c = C.tid & 255;
    const int T = lat ? TL : TC, ms = lat ? MC + b * TL : b * TC;
    const bf16* aLA = WSP(const bf16, WS_LR_LA) + ((size_t)d * MT + ms) * 256 + c; const bf16* aLB = WSP(const bf16, WS_LR_B) + ((size_t)d * MT + ms) * 256 + c;
    bf16* yd = WSP(bf16, WS_YS) + ((size_t)(3 * 2 + d) * MT + ms) * 256 + c;
    float hs = lat ? INP(I_SLR)[((size_t)(b * 4 + l) * 2 + d) * 256 + c] : 0.f;
#pragma unroll 1
    for (int s0 = 0; s0 < T; s0 += 8) {
        float la[8], bb[8];
#pragma unroll
        for (int i = 0; i < 8; ++i) { const int t = d ? T - 1 - (s0 + i) : s0 + i; la[i] = bf2f(aLA[(size_t)t * 256]); bb[i] = bf2f(aLB[(size_t)t * 256]); }
#pragma unroll
        for (int i = 0; i < 8; ++i) { const int t = d ? T - 1 - (s0 + i) : s0 + i; hs = __expf(la[i]) * hs + bb[i]; yd[(size_t)t * 256] = (bf16)f2bf(hs); }
    }
    if (!lat) C.out[O_SLR + ((size_t)(b * 4 + l) * 2 + d) * 256 + c] = hs;
}

__device__ __forceinline__ void scan_dispatch(const Ctx& C, int l, int lat, int jid) {
    const int per = lat ? 64 : 512; const int mixer = jid / per, r = jid - mixer * per;
    const int b = r >> 4, d = (r >> 3) & 1, h = (r >> 1) & 3, rb = r & 1;
    if (mixer == 0) scan_rwkv(C, l, lat, b, d, h, rb); else if (mixer == 1) scan_hgrn(C, l, lat, b, d, h, rb); else scan_ssd(C, l, lat, b, d, h, rb);
}
__device__ __forceinline__ void phase_scans(const Ctx& C, int l) {
    const int w = C.wg;
    if (C.G == 256) {
#pragma unroll 1
        for (int i = 0; i < 10; ++i) {
            int kind = 0, id = 0;
            if (w < 192) { if (i == 0) { kind = 1; id = w; } else if (i <= 5) { kind = 2; id = 5 * w + i - 1; } }
            else { const int x = w - 192; if (i == 0) { kind = x < 36 ? 3 : 0; id = x; } else { kind = 2; id = 960 + 9 * x + i - 1; } }
            asm volatile("" : "+s"(kind), "+s"(id));
            if (kind == 1 || kind == 2) scan_dispatch(C, l, kind == 1 ? 1 : 0, id);
            else if (kind == 3) scan_lru(C, l, id >= 32 ? 1 : 0, id >= 32 ? id - 32 : id);
        }
    } else {
#pragma unroll 1
        for (int j = w; j < 192 + 1536 + 36; j += C.G) {
            int kind = j < 192 ? 1 : (j < 1728 ? 2 : 3), id = j < 192 ? j : (j < 1728 ? j - 192 : j - 1728);
            asm volatile("" : "+s"(kind), "+s"(id));
            if (kind == 1 || kind == 2) scan_dispatch(C, l, kind == 1 ? 1 : 0, id);
            else scan_lru(C, l, id >= 32 ? 1 : 0, id >= 32 ? id - 32 : id);
        }
    }
}

__device__ __forceinline__ void ld4bf(const bf16* p, float (&o)[4]) { const unsigned long long w = *(const GAS unsigned long long*)p; o[0] = bflo((unsigned)w); o[1] = bfhi((unsigned)w); o[2] = bflo((unsigned)(w >> 32)); o[3] = bfhi((unsigned)(w >> 32)); }
__device__ __forceinline__ void st4bf(bf16* p, const float (&o)[4]) { *(GAS unsigned long long*)p = (unsigned long long)pk2(o[0], o[1]) | ((unsigned long long)pk2(o[2], o[3]) << 32); }
__device__ __forceinline__ void phase_post(const Ctx& C, int l) {
    const int gw = C.wg * NWAVES + C.wave, NGW = C.G * NWAVES, lane = C.lane, c4 = 4 * lane, h = lane >> 4;
    const bf16* YS = WSP(const bf16, WS_YS); const bf16* PROJ = WSP(const bf16, WS_PROJ); bf16* MIX = WSP(bf16, WS_MIX);
    const f4 lnw = *(const f4*)(INP(I_RWLNW) + l * 256 + c4), lnb = *(const f4*)(INP(I_RWLNB) + l * 256 + c4), hgn = *(const f4*)(INP(I_HGNORM) + l * 256 + c4), ssn = *(const f4*)(INP(I_SSNORM) + l * 256 + c4);
    const float Dh = INP(I_SSD)[l * 4 + h];
    const size_t YA = (size_t)MT * 256;
    for (int m = gw; m < MT; m += NGW) {
        const size_t mo = (size_t)m * 256 + c4; float a[4], b[4], o[4];
        { ld4bf(YS + 0 * YA + mo, a); ld4bf(YS + 1 * YA + mo, b); float y[4], s = 0.f;
#pragma unroll
          for (int i = 0; i < 4; ++i) { y[i] = a[i] + b[i]; s += y[i]; }
          const float mean = sum16(s) * (1.f / 64.f); float qv = 0.f;
#pragma unroll
          for (int i = 0; i < 4; ++i) { y[i] -= mean; qv += y[i] * y[i]; }
          const float rs = rsqrtf(sum16(qv) * (1.f / 64.f) + 64e-5f);
          float vv[4], gg[4]; ld4bf(WSP(const bf16, WS_RW_V) + mo, vv); ld4bf(WSP(const bf16, WS_RW_G) + mo, gg);
          const float bon = WSP(const float, WS_RW_BON)[(size_t)m * 4 + h];
#pragma unroll
          for (int i = 0; i < 4; ++i) o[i] = (y[i] * rs * lnw[i] + lnb[i] + bon * vv[i]) * gg[i];
          st4bf(MIX + (size_t)m * DM + c4, o); }
        { ld4bf(YS + 2 * YA + mo, a); ld4bf(YS + 3 * YA + mo, b); float y[4], s = 0.f;
#pragma unroll
          for (int i = 0; i < 4; ++i) { y[i] = a[i] + b[i]; s += y[i] * y[i]; }
          const float rs = rsqrtf(wave_sum(s) * (1.f / 256.f) + 1e-6f);
          float gp[4]; ld4bf(PROJ + (size_t)m * PINP + C_HG_G + c4, gp);
#pragma unroll
          for (int i = 0; i < 4; ++i) o[i] = y[i] * rs * hgn[i] * siluf_(gp[i]);
          st4bf(MIX + (size_t)m * DM + 256 + c4, o); }
        { ld4bf(YS + 4 * YA + mo, a); ld4bf(YS + 5 * YA + mo, b); float xx[4], zz[4], y[4], s = 0.f; ld4bf(WSP(const bf16, WS_SS_X) + mo, xx); ld4bf(PROJ + (size_t)m * PINP + C_SS_Z + c4, zz);
#pragma unroll
          for (int i = 0; i < 4; ++i) { y[i] = (a[i] + b[i] + Dh * xx[i]) * siluf_(zz[i]); s += y[i] * y[i]; }
          const float rs = rsqrtf(wave_sum(s) * (1.f / 256.f) + 1e-6f);
#pragma unroll
          for (int i = 0; i < 4; ++i) o[i] = y[i] * rs * ssn[i];
          st4bf(MIX + (size_t)m * DM + 512 + c4, o); }
        { ld4bf(YS + 6 * YA + mo, a); ld4bf(YS + 7 * YA + mo, b); float yb[4]; ld4bf(PROJ + (size_t)m * PINP + C_LR_Y + c4, yb);
#pragma unroll
          for (int i = 0; i < 4; ++i) o[i] = (a[i] + b[i]) * gelu_tanh(yb[i]);
          st4bf(MIX + (size_t)m * DM + 768 + c4, o); }
    }
}

struct Args { const float* in[N_IN]; float* out; unsigned char* ws; int ph_lo, ph_hi; };
constexpr int N_PHASES = 2 + 9 * DEPTH;
#ifndef MKEN
#define MKEN 0xFFFF
#endif
#define EN(x) ((MKEN >> (x)) & 1)
__global__ void __launch_bounds__(NWAVES * 64, 2) mk_fwd(Args args) {
    extern __shared__ __attribute__((aligned(16))) unsigned char lds_raw[];
    Ctx C;
    C.out = args.out; C.ws = args.ws;
    C.lds = (LAS unsigned char*)lds_raw;
    C.tid = threadIdx.x; C.lane = C.tid & 63; C.wave = __builtin_amdgcn_readfirstlane(C.tid >> 6);
    C.G = gridDim.x; C.wg = blockIdx.x;
    volatile LAS unsigned* MISC = (volatile LAS unsigned*)(C.lds + MISC_OFF);
    for (int u = C.tid; u < (LDS_BYTES - LDSCTL_OFF) / 4; u += NWAVES * 64) ((LAS unsigned*)(C.lds + LDSCTL_OFF))[u] = 0u;
    __syncthreads();
    if (C.tid == 0) {
#pragma unroll
        for (int i = 0; i < N_IN; ++i) *(LAS unsigned long long*)(C.lds + PTAB_OFF + 8 * i) = (unsigned long long)args.in[i];
    }
    __syncthreads();
    const int lo = args.ph_lo, hi = args.ph_hi;
    XcdBarrier bar; bar.bar = (unsigned*)(C.ws + WS_CTL) + CW_BAR; bar.x = 0; bar.st = nullptr;
    if (hi - lo > 1) bar = xcd_barrier_post((unsigned*)(C.ws + WS_CTL) + CW_BAR, MISC + 8);
#define IN(k) (lo <= (k) && (k) < hi)
#define SEAM(k) do { if (IN(k) && IN((k) + 1)) xcd_barrier(bar); RELAUNDER(); } while (0)
#define RELAUNDER() do { int t_ = threadIdx.x; asm volatile("" : "+v"(t_)); C.tid = t_; C.lane = t_ & 63; C.wave = __builtin_amdgcn_readfirstlane(t_ >> 6); } while (0)
    if (EN(0) && IN(0)) { p0_prologue(C); } SEAM(0);
    if (EN(1) && IN(1)) { phase_norm_in(C); } SEAM(1);
#pragma unroll 1
    for (int l = 0; l < DEPTH; ++l) {
        const int p0 = 2 + 9 * l;
        if (EN(2) && IN(p0 + 0)) {
            pg8::Gemm g{WSP(const bf16, WS_H), WSP(const bf16, WS_WIN) + (size_t)l * PINP * DM, MT, PINP, DM}; pg8::StaticOrder S; S.init(MT, PINP, C.G, C.wg);
            pg8::EpiBf16<0> E{WSP(bf16, WS_PROJ), PINP};
            pg8::gemm_phase<pg8::EpiBf16<0>, pg8::StaticOrder, PG8_ALIGN, PG8_SP2>(C.lds, g, S, E);
        } SEAM(p0 + 0);
        if (EN(3) && IN(p0 + 1)) { for (int t = C.wg; t < MT / 16; t += C.G) prep_tile(C, l, t); } SEAM(p0 + 1);
        if (EN(4) && IN(p0 + 2)) { phase_scans(C, l); } SEAM(p0 + 2);
        if (EN(5) && IN(p0 + 3)) { phase_post(C, l); } SEAM(p0 + 3);
        if (EN(6) && IN(p0 + 4)) {
            pg8::Gemm g{WSP(const bf16, WS_MIX), WSP(const bf16, WS_WOUT) + (size_t)l * DM * DM, MT, DM, DM}; pg8::StaticOrder S; S.init(MT, DM, C.G, C.wg);
            pg8::EpiF32 E{WSP(float, WS_GO), DM};
            pg8::gemm_phase<pg8::EpiF32, pg8::StaticOrder, PG8_ALIGN, PG8_SP2>(C.lds, g, S, E);
        } SEAM(p0 + 4);
        if (EN(7) && IN(p0 + 5)) { phase_norm_res(C, l, 0); } SEAM(p0 + 5);
        if (EN(8) && IN(p0 + 6)) {
            pg8::Gemm g{WSP(const bf16, WS_H), WSP(const bf16, WS_W1) + (size_t)l * FFD * DM, MT, FFD, DM}; pg8::StaticOrder S; S.init(MT, FFD, C.G, C.wg);
            pg8::EpiBf16<2> E{WSP(bf16, WS_U), FFD};
            pg8::gemm_phase<pg8::EpiBf16<2>, pg8::StaticOrder, PG8_ALIGN, PG8_SP2>(C.lds, g, S, E);
        } SEAM(p0 + 6);
        if (EN(9) && IN(p0 + 7)) {
            pg8::Gemm g{WSP(const bf16, WS_U), WSP(const bf16, WS_W2) + (size_t)l * DM * FFD, MT, DM, FFD}; pg8::StaticOrder S; S.init(MT, DM, C.G, C.wg);
            pg8::EpiF32 E{WSP(float, WS_GO), DM};
            pg8::gemm_phase<pg8::EpiF32, pg8::StaticOrder, PG8_ALIGN, PG8_SP2>(C.lds, g, S, E);
        } SEAM(p0 + 7);
        if (EN(10) && IN(p0 + 8)) { phase_norm_res(C, l, 1); } SEAM(p0 + 8);
    }
#undef IN
#undef SEAM
}

extern "C" void kernel_launch(void* const* d_in, const int* in_sizes, int n_in, void* d_out, int out_size, void* d_ws, size_t ws_size, hipStream_t stream) {
    static int grid = 0;
    if (grid == 0) {
        if (n_in != N_IN || (size_t)out_size != O_END || ws_size < WS_END) { fprintf(stderr, "kernel_launch: unexpected shapes: n_in %d out %d ws %zu (need %zu)\n", n_in, out_size, ws_size, (size_t)WS_END); grid = -1; return; }
        int dev = 0, cus = 0, per_cu = 0;
        if (hipGetDevice(&dev) != hipSuccess || hipDeviceGetAttribute(&cus, hipDeviceAttributeMultiprocessorCount, dev) != hipSuccess) { grid = -1; return; }
        if (hipFuncSetAttribute((const void*)mk_fwd, hipFuncAttributeMaxDynamicSharedMemorySize, LDS_BYTES) != hipSuccess) { fprintf(stderr, "kernel_launch: hipFuncSetAttribute failed\n"); grid = -1; return; }
        if (hipOccupancyMaxActiveBlocksPerMultiprocessor(&per_cu, (const void*)mk_fwd, NWAVES * 64, LDS_BYTES) != hipSuccess || per_cu < 1) { fprintf(stderr, "kernel_launch: occupancy query says %d blocks per CU\n", per_cu); (void)hipGetLastError(); grid = -1; return; }
        grid = cus;
    }
    if (grid < 0) return;
    if (hipMemsetAsync((char*)d_ws + WS_CTL, 0, CTL_ZERO_BYTES, stream) != hipSuccess) return;
    Args a{};
    for (int i = 0; i < N_IN; ++i) a.in[i] = (const float*)d_in[i];
    a.out = (float*)d_out; a.ws = (unsigned char*)d_ws;
#if MK_SINGLE
    a.ph_lo = 0; a.ph_hi = N_PHASES;
    void* kargs[] = {&a};
    hipError_t e = hipLaunchCooperativeKernel((const void*)mk_fwd, dim3(grid), dim3(NWAVES * 64), kargs, LDS_BYTES, stream);
    if (e != hipSuccess) fprintf(stderr, "kernel_launch: cooperative launch failed: %s (grid %d)\n", hipGetErrorString(e), grid);
#else
    for (int p = 0; p < N_PHASES; ++p) { a.ph_lo = p; a.ph_hi = p + 1; hipLaunchKernelGGL(mk_fwd, dim3(grid), dim3(NWAVES * 64), LDS_BYTES, stream, a); }
#endif
}
```

```cpp
#include <hip/hip_runtime.h>
#include <cstdio>
#include <cstdint>
namespace pg8 {
#define PG8_LAS __attribute__((address_space(3)))
typedef unsigned short bf16_t;
typedef short bf16x8 __attribute__((ext_vector_type(8)));
typedef float f32x4 __attribute__((ext_vector_type(4)));
typedef unsigned u32x4 __attribute__((ext_vector_type(4)));
constexpr int BM = 256, BK = 64, HALF = 128, HTB = HALF * BK * 2  , STAGE_BYTES = 8 * HTB, NXCD = 8, WGM = 8;

__host__ __device__ __forceinline__ int lds_byte(int r, int c) { const int st = (r >> 4) * 2 + (c >> 5), rr = r & 15, cc = c & 31, ob = rr * 64 + cc * 2; return st * 1024 + (ob ^ (((ob >> 9) & 1) << 5)); }
__host__ __device__ __forceinline__ void stage_rc(int b, int& R, int& C) { const int st = b / 1024, sb = b % 1024, swz = sb ^ (((sb >> 9) & 1) << 5); R = (st >> 1) * 16 + swz / 64; C = (st & 1) * 32 + (swz % 64) / 2; }
__host__ __device__ __forceinline__ int perm32(int rho) { const int n = rho >> 4, i = rho & 15; return 8 * (i >> 2) + 4 * n + (i & 3); }

struct Unit { int pm, pn; };
struct Gemm { const bf16_t* A; const bf16_t* Bt; int M, N, K; };

struct StaticOrder {
    int nM, nN, nwg, G, c;
    __host__ __device__ void init(int M, int N, int G_, int c_) { nM = M / BM; nN = N / BM; nwg = nM * nN; G = G_; c = c_; }
    __host__ __device__ bool next(int i, Unit& u) const {
        const long L = (long)i * G + c; if (L >= nwg) return false;
        int wgid = (int)L; { const int q = nwg / NXCD, r = nwg % NXCD, xcd = wgid % NXCD, off = wgid / NXCD; wgid = (xcd < r ? xcd * (q + 1) : r * (q + 1) + (xcd - r) * q) + off; }
        const int nig = WGM * nN, gid = wgid / nig, fm = gid * WGM, gsz = (nM - fm) < WGM ? (nM - fm) : WGM;
        u.pm = fm + ((wgid % nig) % gsz); u.pn = (wgid % nig) / gsz; return true;
    }
    __device__ __forceinline__ void a_ready(const Unit&) const {}
    __device__ __forceinline__ void done(const Unit&) const {}
};

__device__ __forceinline__ unsigned cvt_pk_bf16(float lo, float hi) { unsigned r; asm volatile("v_cvt_pk_bf16_f32 %0, %1, %2" : "=v"(r) : "v"(lo), "v"(hi)); return r; }
typedef float f32x2 __attribute__((ext_vector_type(2)));
__device__ __forceinline__ f32x2 gelu_pk(f32x2 v) {
    const f32x2 av = __builtin_elementwise_abs(v), d = av * 0.2316418882f + 1.0f;
    f32x2 t; t.x = __builtin_amdgcn_rcpf(d.x); t.y = __builtin_amdgcn_rcpf(d.y);
    f32x2 q = t * 0.5307027145f + (-0.7265760135f); q = q * t + 0.7107068705f; q = q * t + (-0.142248368f); q = q * t + 0.127414796f; q = q * t;
    const f32x2 s = (v * v) * (-0.72134752044f);
    f32x2 e; e.x = __builtin_amdgcn_exp2f(s.x); e.y = __builtin_amdgcn_exp2f(s.y);
    const f32x2 m = v * (q * e), r = v - m;
    f32x2 o; o.x = v.x < 0.f ? m.x : r.x; o.y = v.y < 0.f ? m.y : r.y; return o;
}

template <int ACT  > struct EpiBf16 {
    static constexpr bool PERM = true, AFTER_DRAIN = false;
    bf16_t* O; int ldc;
    __device__ __forceinline__ void operator()(const f32x4 (&acc)[2][2][4][2], const Unit& u, int wr, int wc, int fr, int fq) const {
        const int row0 = u.pm * BM + wr * 64 + fr; const int col0 = u.pn * BM + wc * 32 + 8 * fq;
#pragma unroll
        for (int ai = 0; ai < 2; ++ai)
#pragma unroll
            for (int m = 0; m < 4; ++m) { bf16_t* rowp = O + (size_t)(row0 + ai * HALF + m * 16) * ldc + col0;
#pragma unroll
                for (int bj = 0; bj < 2; ++bj) { f32x4 v0 = acc[ai][bj][m][0], v1 = acc[ai][bj][m][1];
                    if (ACT == 2) {
#pragma unroll
                        for (int e = 0; e < 4; ++e) { float a = fmaxf(v0[e], 0.f), b = fmaxf(v1[e], 0.f); v0[e] = a * a; v1[e] = b * b; } }
                    u32x4 w; w.x = cvt_pk_bf16(v0[0], v0[1]); w.y = cvt_pk_bf16(v0[2], v0[3]); w.z = cvt_pk_bf16(v1[0], v1[1]); w.w = cvt_pk_bf16(v1[2], v1[3]);
                    *(u32x4*)(rowp + bj * HALF) = w; } }
    }
};
struct EpiF32 {
    static constexpr bool PERM = false, AFTER_DRAIN = false;
    float* O; int ldc;
    __device__ __forceinline__ void operator()(const f32x4 (&acc)[2][2][4][2], const Unit& u, int wr, int wc, int fr, int fq) const {
        const int col0 = u.pn * BM + wc * 32 + 4 * fq;
#pragma unroll
        for (int ai = 0; ai < 2; ++ai)
#pragma unroll
            for (int m = 0; m < 4; ++m) { const size_t off = (size_t)(u.pm * BM + ai * HALF + wr * 64 + m * 16 + fr) * ldc + col0;
#pragma unroll
                for (int bj = 0; bj < 2; ++bj)
#pragma unroll
                    for (int n = 0; n < 2; ++n) *(f32x4*)(O + off + bj * HALF + n * 16) = acc[ai][bj][m][n]; }
    }
};
template <class Epi, class Sched, bool ALIGN_EPI = false, bool SP2 = false>
__device__ __forceinline__ void gemm_phase(PG8_LAS unsigned char* lds, const Gemm g, const Sched& S, const Epi& E) {
    int tid_ = threadIdx.x; asm volatile("" : "+v"(tid_));
    const int tid = tid_, wid = __builtin_amdgcn_readfirstlane(tid >> 6), lane = tid & 63, wr = wid >> 2, wc = wid & 3, fr = lane & 15, fq = lane >> 4;
    const int K = g.K, nt = K / BK;
    unsigned voffA[2], voffB[2];
#pragma unroll
    for (int i = 0; i < 2; ++i) { int R, C; stage_rc(tid * 16 + i * 8192, R, C); const int Rb = Epi::PERM ? ((R & ~31) + perm32(R & 31)) : R;
        voffA[i] = (unsigned)(R * K + C) * 2u; voffB[i] = (unsigned)(Rb * K + C) * 2u; }
    const size_t kstep = (size_t)(BK * 2);
    const size_t hstep = (size_t)HALF * K * 2;
    const size_t tstep = 2 * hstep;
    const unsigned ldsw = (unsigned)wid * 1024u;
    const int aoff = lds_byte(wr * 64 + fr, fq * 8), boff = lds_byte(wc * 32 + fr, fq * 8);
#define PG8_SA(b, h) (((b) * 2 + (h)) * HTB)
#define PG8_SB(b, h) ((4 + (b) * 2 + (h)) * HTB)
#define PG8_STAGE(bufoff, gbase, voff) do { _Pragma("unroll") for (int _i = 0; _i < 2; ++_i) \
        __builtin_amdgcn_global_load_lds((const unsigned*)((const char*)(gbase) + (voff)[_i]), (PG8_LAS unsigned*)(lds + (bufoff) + ldsw + _i * 8192), 16, 0, 0); } while (0)
#define PG8_LDA(dst, b, h) do { _Pragma("unroll") for (int m = 0; m < 4; ++m) _Pragma("unroll") for (int k = 0; k < 2; ++k) dst[m][k] = *(const PG8_LAS bf16x8*)(lds + PG8_SA(b, h) + aoff + m * 2048 + k * 1024); } while (0)
#define PG8_LDB(dst, b, h) do { _Pragma("unroll") for (int n = 0; n < 2; ++n) _Pragma("unroll") for (int k = 0; k < 2; ++k) dst[n][k] = *(const PG8_LAS bf16x8*)(lds + PG8_SB(b, h) + boff + n * 2048 + k * 1024); } while (0)
#define PG8_MMA(ai, bj, At, Bt) do { __builtin_amdgcn_s_setprio(1); _Pragma("unroll") for (int m = 0; m < 4; ++m) _Pragma("unroll") for (int n = 0; n < 2; ++n) _Pragma("unroll") for (int k = 0; k < 2; ++k) \
        acc[ai][bj][m][n] = __builtin_amdgcn_mfma_f32_16x16x32_bf16(Bt[n][k], At[m][k], acc[ai][bj][m][n], 0, 0, 0); __builtin_amdgcn_s_setprio(0); } while (0)
#define PG8_WAIT_V(n) asm volatile("s_waitcnt vmcnt(" #n ")" ::: "memory")
#define PG8_WAIT_L(n) asm volatile("s_waitcnt lgkmcnt(" #n ")" ::: "memory")
#define PG8_BAR __builtin_amdgcn_s_barrier()
#define PG8_SCHED __builtin_amdgcn_sched_barrier(0)
    Unit cur, nxt; int ui = 0;
    if (!S.next(0, cur)) return;
    f32x4 acc[2][2][4][2];
#pragma unroll
    for (int a = 0; a < 2; ++a)
#pragma unroll
        for (int b = 0; b < 2; ++b)
#pragma unroll
            for (int m = 0; m < 4; ++m)
#pragma unroll
                for (int n = 0; n < 2; ++n) acc[a][b][m][n] = (f32x4){0.f, 0.f, 0.f, 0.f};
    bf16x8 At[4][2], B0[2][2], B1[2][2];
    const char* cA = (const char*)g.A + (size_t)cur.pm * tstep; const char* cB = (const char*)g.Bt + (size_t)cur.pn * tstep;
    S.a_ready(cur);
    if constexpr (SP2) {
        PG8_STAGE(PG8_SB(0, 0), cB, voffB); PG8_STAGE(PG8_SB(0, 1), cB + hstep, voffB); PG8_STAGE(PG8_SA(0, 0), cA, voffA); PG8_STAGE(PG8_SA(0, 1), cA + hstep, voffA);
        if (wr == 1) PG8_BAR;
        PG8_WAIT_V(2); PG8_BAR;
        PG8_STAGE(PG8_SB(1, 0), cB + kstep, voffB); PG8_STAGE(PG8_SA(1, 0), cA + kstep, voffA); PG8_STAGE(PG8_SB(1, 1), cB + hstep + kstep, voffB);
        PG8_WAIT_V(6); PG8_BAR;
    } else {
        PG8_STAGE(PG8_SB(0, 0), cB, voffB); PG8_STAGE(PG8_SA(0, 0), cA, voffA); PG8_STAGE(PG8_SB(0, 1), cB + hstep, voffB); PG8_STAGE(PG8_SA(0, 1), cA + hstep, voffA);
        if (wr == 1) PG8_BAR;
        PG8_WAIT_V(4); PG8_BAR;
        PG8_STAGE(PG8_SB(1, 0), cB + kstep, voffB); PG8_STAGE(PG8_SA(1, 0), cA + kstep, voffA); PG8_STAGE(PG8_SB(1, 1), cB + hstep + kstep, voffB);
        PG8_WAIT_V(6); PG8_BAR;
    }
    for (;;) {
        const bool has_next = S.next(ui + 1, nxt);
        const char* nA = has_next ? (const char*)g.A + (size_t)nxt.pm * tstep : cA; const char* nB = has_next ? (const char*)g.Bt + (size_t)nxt.pn * tstep : cB;
        for (int t = 0; t < nt; t += 2) {
            const bool last = (t == nt - 2);
            const char* a1 = cA + (size_t)(t + 1) * kstep;
            const char* a2 = last ? nA : cA + (size_t)(t + 2) * kstep; const char* b2 = last ? nB : cB + (size_t)(t + 2) * kstep;
            const char* a3 = a2 + kstep; const char* b3 = b2 + kstep;
            if (last && has_next) S.a_ready(nxt);
            if constexpr (SP2) {
            PG8_LDB(B0, 0, 0); PG8_LDB(B1, 0, 1); PG8_SCHED; PG8_LDA(At, 0, 0); PG8_STAGE(PG8_SA(1, 1), a1 + hstep, voffA);
            PG8_WAIT_V(8); PG8_WAIT_L(0); PG8_BAR; PG8_MMA(0, 0, At, B0); PG8_MMA(0, 1, At, B1); PG8_BAR; PG8_SCHED;
            PG8_LDA(At, 0, 1); PG8_STAGE(PG8_SB(0, 0), b2, voffB); PG8_STAGE(PG8_SB(0, 1), b2 + hstep, voffB); PG8_STAGE(PG8_SA(0, 0), a2, voffA);
            PG8_WAIT_V(8); PG8_WAIT_L(0); PG8_BAR; PG8_MMA(1, 0, At, B0); PG8_MMA(1, 1, At, B1); PG8_BAR; PG8_SCHED;
            PG8_LDB(B0, 1, 0); PG8_LDB(B1, 1, 1); PG8_SCHED; PG8_LDA(At, 1, 0); PG8_STAGE(PG8_SA(0, 1), a2 + hstep, voffA);
            PG8_WAIT_V(8); PG8_WAIT_L(0); PG8_BAR; PG8_MMA(0, 0, At, B0); PG8_MMA(0, 1, At, B1); PG8_BAR; PG8_SCHED;
            PG8_LDA(At, 1, 1); PG8_STAGE(PG8_SB(1, 0), b3, voffB); PG8_STAGE(PG8_SB(1, 1), b3 + hstep, voffB); PG8_STAGE(PG8_SA(1, 0), a3, voffA);
            PG8_WAIT_V(8); PG8_WAIT_L(0); PG8_BAR; PG8_MMA(1, 0, At, B0); PG8_MMA(1, 1, At, B1); PG8_BAR; PG8_SCHED;
            } else {
            PG8_LDB(B0, 0, 0); PG8_SCHED; PG8_LDA(At, 0, 0); PG8_STAGE(PG8_SA(1, 1), a1 + hstep, voffA);
            PG8_WAIT_L(8); PG8_BAR; PG8_WAIT_L(0); PG8_MMA(0, 0, At, B0); PG8_BAR; PG8_SCHED;
            PG8_LDB(B1, 0, 1); PG8_STAGE(PG8_SB(0, 0), b2, voffB);
            PG8_BAR; PG8_WAIT_L(0); PG8_MMA(0, 1, At, B1); PG8_BAR;
            PG8_LDA(At, 0, 1); PG8_STAGE(PG8_SA(0, 0), a2, voffA);
            PG8_BAR; PG8_WAIT_L(0); PG8_MMA(1, 0, At, B0); PG8_BAR; PG8_SCHED;
            PG8_STAGE(PG8_SB(0, 1), b2 + hstep, voffB);
            PG8_WAIT_V(6); PG8_BAR; PG8_MMA(1, 1, At, B1); PG8_BAR;
            PG8_LDB(B0, 1, 0); PG8_SCHED; PG8_LDA(At, 1, 0); PG8_STAGE(PG8_SA(0, 1), a2 + hstep, voffA);
            PG8_WAIT_L(8); PG8_BAR; PG8_WAIT_L(0); PG8_MMA(0, 0, At, B0); PG8_BAR; PG8_SCHED;
            PG8_LDB(B1, 1, 1); PG8_STAGE(PG8_SB(1, 0), b3, voffB);
            PG8_BAR; PG8_WAIT_L(0); PG8_MMA(0, 1, At, B1); PG8_BAR;
            PG8_LDA(At, 1, 1); PG8_STAGE(PG8_SA(1, 0), a3, voffA);
            PG8_BAR; PG8_WAIT_L(0); PG8_MMA(1, 0, At, B0); PG8_BAR; PG8_SCHED;
            PG8_STAGE(PG8_SB(1, 1), b3 + hstep, voffB);
            PG8_WAIT_V(6); PG8_BAR; PG8_MMA(1, 1, At, B1); PG8_BAR;
            }
        }
        if constexpr (ALIGN_EPI) { if (wr == 0) PG8_BAR; }
        if constexpr (!Epi::AFTER_DRAIN) { E(acc, cur, wr, wc, fr, fq); S.done(cur); }
        if (!has_next) break;
#pragma unroll
        for (int a = 0; a < 2; ++a)
#pragma unroll
            for (int b = 0; b < 2; ++b)
#pragma unroll
                for (int m = 0; m < 4; ++m)
#pragma unroll
                    for (int n = 0; n < 2; ++n) acc[a][b][m][n] = (f32x4){0.f, 0.f, 0.f, 0.f};
        cur = nxt; cA = nA; cB = nB; ++ui;
        if constexpr (ALIGN_EPI) { if (wr == 1) PG8_BAR; }
    }
    PG8_WAIT_V(0);
    if constexpr (!ALIGN_EPI) { if (wr == 0) PG8_BAR; }
    PG8_BAR;
    if constexpr (Epi::AFTER_DRAIN) { E.fused(acc, cur, wr, wc, fr, fq, lds, wid, lane); S.done(cur); }
#undef PG8_SA
#undef PG8_SB
#undef PG8_STAGE
#undef PG8_LDA
#undef PG8_LDB
#undef PG8_MMA
#undef PG8_WAIT_V
#undef PG8_WAIT_L
#undef PG8_BAR
#undef PG8_SCHED
}
}

#ifndef PG8_SP2
#define PG8_SP2 true
#endif
#ifndef PG8_ALIGN
#define PG8_ALIGN true
#endif
#if defined(__HIP_DEVICE_COMPILE__)
#define GAS __attribute__((address_space(1)))
#else
#define GAS
#endif
#define LAS __attribute__((address_space(3)))
typedef unsigned short bf16;
typedef unsigned v4u __attribute__((ext_vector_type(4)));
typedef float f32x4 __attribute__((ext_vector_type(4)));
typedef short bf16x8 __attribute__((ext_vector_type(8)));
typedef GAS unsigned gu32;
typedef GAS unsigned long long gu64;
#define RLX_AGENT __ATOMIC_RELAXED, __HIP_MEMORY_SCOPE_AGENT
#define LDS_WAIT() asm volatile("s_waitcnt lgkmcnt(0)" ::: "memory")
#define VM_WAIT() asm volatile("s_waitcnt vmcnt(0)" ::: "memory")
__device__ __forceinline__ unsigned long long rt() { return __builtin_amdgcn_s_memrealtime(); }
__device__ __forceinline__ unsigned f2bf(float f) { unsigned u = __builtin_bit_cast(unsigned, f); return (u + 0x7fffu + ((u >> 16) & 1u)) >> 16; }
__device__ __forceinline__ unsigned pk2(float lo, float hi) { return f2bf(lo) | (f2bf(hi) << 16); }

#define XB_TMO      128
#define XB_XCNT(j)  (256  + 64 * (j))
#define XB_XSUB(j)  (1280 + 64 * (j))
#define XB_XGEN(j)  (2304 + 64 * (j))
#define XB_TOP      3328
#define XB_TOPGEN   3392
#define XCD_BAR_WORDS 3456
#define XB_SPIN_CAP (1u << 18)

__device__ __forceinline__ unsigned xb_ld(unsigned* p)              { return __hip_atomic_load(p, __ATOMIC_RELAXED, __HIP_MEMORY_SCOPE_AGENT); }
__device__ __forceinline__ unsigned xb_add(unsigned* p, unsigned v) { return __hip_atomic_fetch_add(p, v, __ATOMIC_RELAXED, __HIP_MEMORY_SCOPE_AGENT); }
__device__ __forceinline__ unsigned xb_xcc_id() { return (unsigned)__builtin_amdgcn_s_getreg((3 << 11) | 20) & 0xFu; }
#define XB_SPIN(cond, bar) do { unsigned _sp = 0; while (cond) { __builtin_amdgcn_s_sleep(1); \
    if ((++_sp & 255u) == 0u) { if (xb_ld(&(bar)[XB_TMO])) break; if (_sp > XB_SPIN_CAP) { atomicAdd(&(bar)[XB_TMO], 1u); break; } } } } while (0)

struct XcdBarrier {
    unsigned* bar; unsigned x;
    volatile LAS unsigned* st;
};

__device__ __forceinline__ XcdBarrier xcd_barrier_post(unsigned* bar, volatile LAS unsigned* st) {
    XcdBarrier b; b.bar = bar; b.x = xb_xcc_id(); b.st = st;
    if (threadIdx.x == 0) (void)xb_add(&bar[XB_XCNT(b.x)], 1u);
    return b;
}
__device__ __forceinline__ void xcd_barrier_complete(unsigned* bar, unsigned x, unsigned& nloc, unsigned& nx) {
    const unsigned G = gridDim.x * gridDim.y * gridDim.z;
    unsigned sum, cnt, mine, sp = 0u;
    for (;;) {
        sum = 0u; cnt = 0u; mine = 0u;
#pragma unroll
        for (unsigned j = 0; j < 16; ++j) { const unsigned c = xb_ld(&bar[XB_XCNT(j)]); sum += c; cnt += (c > 0u) ? 1u : 0u; mine = (j == x) ? c : mine; }
        if (sum == G) break;
        __builtin_amdgcn_s_sleep(1);
        if ((++sp & 255u) == 0u) { if (xb_ld(&bar[XB_TMO])) break; if (sp > XB_SPIN_CAP) { atomicAdd(&bar[XB_TMO], 1u); break; } }
    }
    nloc = mine > 0u ? mine : 1u; nx = cnt > 0u ? cnt : 1u;
}

__device__ __forceinline__ void xcd_barrier(const XcdBarrier& b) {
    asm volatile("s_waitcnt vmcnt(0)" ::: "memory");
    __syncthreads();
    if (threadIdx.x == 0) {
        unsigned* bar = b.bar;
        __builtin_amdgcn_s_waitcnt(0);
        unsigned nloc = b.st[0], nx = b.st[1];
        if (nloc == 0u) { xcd_barrier_complete(bar, b.x, nloc, nx); b.st[0] = nloc; b.st[1] = nx; }
        const unsigned old = xb_add(&bar[XB_XSUB(b.x)], 1u);
        const unsigned gen = old / nloc;
        if (old + 1u == (gen + 1u) * nloc) {
            __builtin_amdgcn_fence(__ATOMIC_RELEASE, "agent");
            asm volatile("s_waitcnt vmcnt(0)" ::: "memory");
            const unsigned og = xb_add(&bar[XB_TOP], 1u);
            const unsigned tg = og / nx;
            if (og + 1u == (tg + 1u) * nx) xb_add(&bar[XB_TOPGEN], 1u);
            else XB_SPIN(xb_ld(&bar[XB_TOPGEN]) == tg, bar);
            __builtin_amdgcn_fence(__ATOMIC_ACQUIRE, "agent");
            xb_add(&bar[XB_XGEN(b.x)], 1u);
            asm volatile("s_waitcnt vmcnt(0)" ::: "memory");
        } else {
            XB_SPIN(xb_ld(&bar[XB_XGEN(b.x)]) == gen, bar);
            __builtin_amdgcn_fence(__ATOMIC_ACQUIRE, "agent");
            asm volatile("s_waitcnt vmcnt(0)" ::: "memory");
        }
    }
    __syncthreads();
}
#ifndef MK_SINGLE
#define MK_SINGLE 1
#endif
constexpr int NWAVES = 8;
constexpr int DM = 1024, MT = 12288, MC = 8192, DEPTH = 4, PIN = 3688, PINP = 3840, FFD = 4096;
constexpr int TC = 256, TL = 1024;
constexpr int C_RW_WD = 768, C_RW_AD = 800, C_RW_GD = 832, RWC = 864;
constexpr int C_HG_Q = 864, C_HG_I = 1120, C_HG_F = 1376, C_HG_G = 1888;
constexpr int C_SS_Z = 2144, C_SS_XBC = 2400, C_SS_DT = 3168;
constexpr int C_LR_Y = 3176, C_LR_X = 3432;
enum { I_XP = 0, I_XS, I_SRW, I_SHG, I_SSS, I_SLR, I_C, I_CCTX, I_MODW, I_MODB, I_NORMG, I_WIN, I_WOUT, I_RWMU, I_RWW0, I_RWW2, I_RWA0, I_RWA2, I_RWG2, I_RWKK, I_RWKA, I_RWRK,
       I_RWLNW, I_RWLNB, I_HGLB, I_HGNORM, I_SSCW, I_SSCB, I_SSDTB, I_SSALOG, I_SSD, I_SSNORM, I_LRCW, I_LRCB, I_LRWA, I_LRBA, I_LRWX, I_LRBX, I_LRLAM, I_W1, I_W2, N_IN };
constexpr size_t O_X = 0, O_SRW = 12582912, O_SHG = 16777216, O_SSS = 20971520, O_SLR = 29360128, O_END = 29425664;
constexpr size_t MiB = 1u << 20;
constexpr size_t WS_CTL = 0, CTL_ZERO_BYTES = 1 * MiB;
constexpr size_t WS_MOD = 1 * MiB;
constexpr size_t WS_LB = 1 * MiB + 512 * 1024;
constexpr size_t WS_WLR = 2 * MiB;
constexpr size_t WS_WIN = 3 * MiB;
constexpr size_t WS_WOUT = 33 * MiB;
constexpr size_t WS_W1 = 41 * MiB;
constexpr size_t WS_W2 = 73 * MiB;
constexpr size_t WS_PROJ = 105 * MiB;
constexpr size_t WS_MIX = 195 * MiB;
constexpr size_t WS_U = WS_PROJ;
constexpr size_t WS_H = 219 * MiB;
constexpr size_t WS_GO = 243 * MiB;
constexpr size_t A6 = 6 * MiB;
constexpr size_t WS_RW_R = 219 * MiB, WS_RW_KK = WS_RW_R + A6, WS_RW_V = WS_RW_KK + A6, WS_RW_KD = WS_RW_V + A6  , WS_RW_B = WS_RW_KD + 2 * A6  ,
                 WS_RW_G = WS_RW_B + 2 * A6, WS_RW_E = WS_RW_G + A6  , WS_RW_BON = WS_RW_E + 2 * A6  ;
constexpr size_t WS_SS_X = WS_RW_BON + 1 * MiB, WS_SS_B = WS_SS_X + A6, WS_SS_C = WS_SS_B + A6, WS_SS_DT = WS_SS_C + A6  , WS_SS_DEC = WS_SS_DT + 512 * 1024;
constexpr size_t WS_LR_LA = WS_SS_DT + 1 * MiB  , WS_LR_B = WS_LR_LA + 2 * A6;
constexpr size_t WS_YS = WS_LR_B + 2 * A6;
constexpr size_t WS_END = WS_YS + 8 * A6;
static_assert(WS_END == 371 * MiB, "ws map");
constexpr int CW_BAR = 4096;
constexpr int RING_BYTES = 131072, LDSCTL_OFF = RING_BYTES, MISC_OFF = LDSCTL_OFF + 320, LDS_BYTES = 147456;

typedef float f4 __attribute__((ext_vector_type(4)));
typedef float f2 __attribute__((ext_vector_type(2)));
__device__ __forceinline__ float bf2f(bf16 v) { return __uint_as_float((unsigned)v << 16); }
__device__ __forceinline__ float bflo(unsigned w) { return __uint_as_float(w << 16); }
__device__ __forceinline__ float bfhi(unsigned w) { return __uint_as_float(w & 0xffff0000u); }
__device__ __forceinline__ float sigmoidf_(float x) { return 1.f / (1.f + __expf(-x)); }
__device__ __forceinline__ float siluf_(float x) { return x / (1.f + __expf(-x)); }
__device__ __forceinline__ float softplusf_(float x) { return x > 20.f ? x : log1pf(__expf(x)); }
__device__ __forceinline__ float gelu_tanh(float x) { const float u = 0.7978845608028654f * (x + 0.044715f * x * x * x); return 0.5f * x * (1.f + tanhf(u)); }
__device__ __forceinline__ float wave_sum(float v) {
#pragma unroll
    for (int o = 1; o < 64; o <<= 1) v += __shfl_xor(v, o);
    return v;
}
template <int CTRL> __device__ __forceinline__ float dppf(float v) {
    return __builtin_bit_cast(float, __builtin_amdgcn_update_dpp(0, __builtin_bit_cast(int, v), CTRL, 0xF, 0xF, true));
}
__device__ __forceinline__ float sum16(float v) {
    v += dppf<0xB1>(v); v += dppf<0x4E>(v); v += dppf<0x141>(v); v += dppf<0x140>(v); return v;
}
__device__ __forceinline__ void cvt8(const v4u w, float (&o)[8]) {
    o[0] = bflo(w.x); o[1] = bfhi(w.x); o[2] = bflo(w.y); o[3] = bfhi(w.y); o[4] = bflo(w.z); o[5] = bfhi(w.z); o[6] = bflo(w.w); o[7] = bfhi(w.w);
}
__device__ __forceinline__ void st8(LAS float* p, const float (&o)[8]) { *(LAS f4*)p = (f4){o[0], o[1], o[2], o[3]}; *(LAS f4*)(p + 4) = (f4){o[4], o[5], o[6], o[7]}; }

struct Ctx {
    float* out; unsigned char* ws;
    int tid, lane, wave, G, wg;
    LAS unsigned char* lds;
};
constexpr int PTAB_OFF = 131584;
typedef const GAS float* gcf;
__device__ __forceinline__ gcf ldptr(const Ctx& C, int i) {
    const LAS unsigned* t = (const LAS unsigned*)(C.lds + PTAB_OFF) + 2 * i;
    const unsigned lo = __builtin_amdgcn_readfirstlane(t[0]), hi = __builtin_amdgcn_readfirstlane(t[1]);
    return (gcf)(((unsigned long long)hi << 32) | (unsigned long long)lo);
}
#define INP(i) ldptr(C, (i))
#define WSP(T, off) ((GAS T*)(C.ws + (off)))

__device__ __forceinline__ void tr_item(const float* W, int K, int N, int Np, bf16* WT, LAS float* scr, int item, int lane) {
    const int nblk = Np / 32, kb = item / nblk, nb = item % nblk, k0 = 64 * kb, n0 = 32 * nb;
    const int nn = n0 + (lane & 31); const bool ok = nn < N;
#pragma unroll 8
    for (int i = 0; i < 32; ++i) { const int kk = 2 * i + (lane >> 5); scr[kk * 33 + (lane & 31)] = ok ? W[(size_t)(k0 + kk) * N + nn] : 0.f; }
    LDS_WAIT(); asm volatile("" ::: "memory");
    const int c = lane & 7;
#pragma unroll
    for (int j = 0; j < 4; ++j) { const int n = (lane >> 3) + 8 * j; const LAS float* s = scr + (8 * c) * 33 + n;
        v4u o; o.x = pk2(s[0 * 33], s[1 * 33]); o.y = pk2(s[2 * 33], s[3 * 33]); o.z = pk2(s[4 * 33], s[5 * 33]); o.w = pk2(s[6 * 33], s[7 * 33]);
        *(GAS v4u*)(WT + (size_t)(n0 + n) * K + k0 + 8 * c) = o; }
    LDS_WAIT(); asm volatile("" ::: "memory");
}
__device__ __forceinline__ void p0_prologue(const Ctx& C) {
    const int gw = C.wg * NWAVES + C.wave, NGW = C.G * NWAVES;
    {
        LAS float* scr = (LAS float*)(C.lds + C.wave * 16384);
        constexpr int I_IN = 16 * (PINP / 32), I_OUT = 16 * 32, I_1 = 16 * (FFD / 32), I_2 = 64 * 32, I_L = I_IN + I_OUT + I_1 + I_2;
        for (int it = gw; it < DEPTH * I_L; it += NGW) {
            const int l = it / I_L; int r = it - l * I_L;
            if (r < I_IN) { tr_item(INP(I_WIN) + (size_t)l * DM * PIN, DM, PIN, PINP, WSP(bf16, WS_WIN) + (size_t)l * PINP * DM, scr, r, C.lane); continue; } r -= I_IN;
            if (r < I_OUT) { tr_item(INP(I_WOUT) + (size_t)l * DM * DM, DM, DM, DM, WSP(bf16, WS_WOUT) + (size_t)l * DM * DM, scr, r, C.lane); continue; } r -= I_OUT;
            if (r < I_1) { tr_item(INP(I_W1) + (size_t)l * DM * FFD, DM, FFD, FFD, WSP(bf16, WS_W1) + (size_t)l * FFD * DM, scr, r, C.lane); continue; } r -= I_1;
            tr_item(INP(I_W2) + (size_t)l * FFD * DM, FFD, DM, DM, WSP(bf16, WS_W2) + (size_t)l * DM * FFD, scr, r, C.lane);
        }
    }
    {
        bf16* WLR = WSP(bf16, WS_WLR);
        for (int o = C.wg * 512 + C.tid; o < DEPTH * 2 * 2 * 4 * 64 * 64; o += C.G * 512) {
            const int i = o & 63, j = (o >> 6) & 63, h = (o >> 12) & 3, g = (o >> 14) & 1, d = (o >> 15) & 1, l = o >> 16;
            const float* src = g ? INP(I_LRWX) : INP(I_LRWA);
            WLR[o] = (bf16)f2bf(src[((((size_t)l * 2 + d) * 4 + h) * 64 + i) * 64 + j]);
        }
    }
    {
        float* LB = WSP(float, WS_LB);
        for (int o = C.wg * 512 + C.tid; o < 512; o += C.G * 512) {
            float v[4], mx = -1e30f;
#pragma unroll
            for (int l = 0; l < 4; ++l) { v[l] = INP(I_HGLB)[l * 512 + o]; mx = fmaxf(mx, v[l]); }
            float s = 0.f;
#pragma unroll
            for (int l = 0; l < 4; ++l) { v[l] = expf(v[l] - mx); s += v[l]; }
            const float inv = 1.f / s; float cum = 0.f;
#pragma unroll
            for (int l = 0; l < 4; ++l) { const float p = v[l] * inv; cum += p; LB[l * 512 + o] = cum - v[0] * inv; }
        }
    }
    __syncthreads();
    {
        LAS float* SC = (LAS float*)C.lds;
        LAS float* RED = SC + 5 * 1024;
        bool staged = false;
        for (int u = C.wg; u < DEPTH * 48; u += C.G) {
            if (!staged) {
                for (int e = C.tid; e < 5 * 1024; e += 512) { const int cnd = e >> 10, k = e & 1023; const float x = cnd == 0 ? INP(I_CCTX)[k] : INP(I_C)[(cnd - 1) * 1024 + k]; SC[e] = siluf_(x); }
                staged = true;
            }
            __syncthreads();
            const int l = u / 48, j0 = (u % 48) * 128 + 2 * C.lane;
            const float* wp = INP(I_MODW) + (size_t)l * DM * 6144 + j0;
            float acc[5][2];
#pragma unroll
            for (int cnd = 0; cnd < 5; ++cnd) { acc[cnd][0] = 0.f; acc[cnd][1] = 0.f; }
            const int kb = C.wave * 128;
#pragma unroll 8
            for (int k = kb; k < kb + 128; ++k) { const f2 w = *(const f2*)(wp + (size_t)k * 6144);
#pragma unroll
                for (int cnd = 0; cnd < 5; ++cnd) { const float s = SC[cnd * 1024 + k]; acc[cnd][0] += s * w.x; acc[cnd][1] += s * w.y; } }
#pragma unroll
            for (int cnd = 0; cnd < 5; ++cnd) { RED[(C.wave * 5 + cnd) * 128 + 2 * C.lane] = acc[cnd][0]; RED[(C.wave * 5 + cnd) * 128 + 2 * C.lane + 1] = acc[cnd][1]; }
            __syncthreads();
            for (int e = C.tid; e < 5 * 128; e += 512) { const int cnd = e >> 7, j = e & 127; float s = 0.f;
#pragma unroll
                for (int w = 0; w < 8; ++w) s += RED[(w * 5 + cnd) * 128 + j];
                const int col = (u % 48) * 128 + j;
                WSP(float, WS_MOD)[((size_t)l * 5 + cnd) * 6144 + col] = s + INP(I_MODB)[l * 6144 + col]; }
        }
        __syncthreads();
    }
}

__device__ __forceinline__ const float* mod_row(const Ctx& C, int l, int m) { const int cnd = m < MC ? 0 : 1 + ((m - MC) >> 10); return WSP(const float, WS_MOD) + ((size_t)l * 5 + cnd) * 6144; }
__device__ __forceinline__ void write_h(const Ctx& C, const f4 (&x)[4], float ssq, const float* g, const float* sc, const float* sh, bf16* hrow) {
    const float rs = rsqrtf(ssq * (1.f / DM) + 1e-6f);
#pragma unroll
    for (int j = 0; j < 4; ++j) { const int c = 4 * C.lane + 256 * j; const f4 gg = *(const f4*)(g + c), s1 = *(const f4*)(sc + c), s0 = *(const f4*)(sh + c);
        const f4 y = x[j] * rs * gg * (1.f + s1) + s0;
        *(GAS unsigned long long*)(hrow + c) = (unsigned long long)pk2(y.x, y.y) | ((unsigned long long)pk2(y.z, y.w) << 32); }
}
__device__ __forceinline__ void phase_norm_in(const Ctx& C) {
    const int gw = C.wg * NWAVES + C.wave, NGW = C.G * NWAVES;
    const float* ng = INP(I_NORMG);
    for (int m = gw; m < MT; m += NGW) {
        const float* xr = m < MC ? INP(I_XP) + (size_t)m * DM : INP(I_XS) + (size_t)(m - MC) * DM;
        float* xo = C.out + O_X + (size_t)m * DM;
        f4 x[4]; float ss = 0.f;
#pragma unroll
        for (int j = 0; j < 4; ++j) { x[j] = *(const f4*)(xr + 4 * C.lane + 256 * j); *(f4*)(xo + 4 * C.lane + 256 * j) = x[j]; ss += (x[j].x * x[j].x + x[j].y * x[j].y) + (x[j].z * x[j].z + x[j].w * x[j].w); }
        ss = wave_sum(ss);
        const float* md = mod_row(C, 0, m);
        write_h(C, x, ss, ng + 0 * DM, md + 1 * DM, md + 0 * DM, WSP(bf16, WS_H) + (size_t)m * DM);
    }
}
__device__ __forceinline__ void phase_norm_res(const Ctx& C, int l, int which) {
    const int gw = C.wg * NWAVES + C.wave, NGW = C.G * NWAVES;
    const float* ng = INP(I_NORMG);
    const float* gpost = ng + ((size_t)l * 4 + (which ? 3 : 1)) * DM;
    const bool wh = which == 0 || l + 1 < DEPTH;
    const int ln = which ? l + 1 : l;
    const float* gpre = ng + ((size_t)ln * 4 + (which ? 0 : 2)) * DM;
    const float* GO = WSP(const float, WS_GO);
    for (int m = gw; m < MT; m += NGW) {
        const float* gr = GO + (size_t)m * DM; float* xo = C.out + O_X + (size_t)m * DM;
        const float* md = mod_row(C, l, m);
        const float* gate = md + (which ? 5 : 2) * DM;
        f4 go[4], x[4]; float ss = 0.f;
#pragma unroll
        for (int j = 0; j < 4; ++j) { go[j] = *(const f4*)(gr + 4 * C.lane + 256 * j); x[j] = *(const f4*)(xo + 4 * C.lane + 256 * j); ss += (go[j].x * go[j].x + go[j].y * go[j].y) + (go[j].z * go[j].z + go[j].w * go[j].w); }
        ss = wave_sum(ss);
        const float rs = rsqrtf(ss * (1.f / DM) + 1e-6f); float s2 = 0.f;
#pragma unroll
        for (int j = 0; j < 4; ++j) { const int c = 4 * C.lane + 256 * j; const f4 gp = *(const f4*)(gpost + c), gt = *(const f4*)(gate + c);
            x[j] = x[j] + gt * (go[j] * rs * gp); *(f4*)(xo + c) = x[j]; s2 += (x[j].x * x[j].x + x[j].y * x[j].y) + (x[j].z * x[j].z + x[j].w * x[j].w); }
        if (wh) {
            s2 = wave_sum(s2);
            const float* md2 = mod_row(C, ln, m);
            write_h(C, x, s2, gpre, md2 + (which ? 1 : 4) * DM, md2 + (which ? 0 : 3) * DM, WSP(bf16, WS_H) + (size_t)m * DM);
        }
    }
}

__device__ __forceinline__ void conv16(const bf16* col, int t0, int T, const float (&w)[4], float bias, float (&y)[16]) {
    float x[19];
#pragma unroll
    for (int i = 0; i < 19; ++i) { const int t = t0 - 2 + i; x[i] = (t >= 0 && t < T) ? bf2f(col[(size_t)t * PINP]) : 0.f; }
#pragma unroll
    for (int j = 0; j < 16; ++j) y[j] = bias + w[0] * x[j] + w[1] * x[j + 1] + w[2] * x[j + 2] + w[3] * x[j + 3];
}
__device__ __forceinline__ void prep_tile(const Ctx& C, int l, int tile) {
    const int tid = C.tid, lane = C.lane;
    const int m0 = tile * 16; const bool lat = m0 >= MC; const int T = lat ? TL : TC;
    const int ms = lat ? MC + (((m0 - MC) >> 10) << 10) : (m0 & ~255); const int t0 = m0 - ms;
    const bf16* PROJ = WSP(const bf16, WS_PROJ);
    LAS float* XM = (LAS float*)C.lds;
    LAS float* TW = XM + 16 * RWC;
    LAS float* SG = TW + 512;
    LAS float* XCf = SG + 512;
    LAS bf16* XCb = (LAS bf16*)(XCf + 4096);
#ifndef PREP_EN
#define PREP_EN 0xFF
#endif
    const float* mu = INP(I_RWMU) + l * RWC;
    for (int idx = tid; idx < 16 * RWC; idx += 512) {
        const int j = idx / RWC, c = idx - j * RWC, t = t0 + j, m = m0 + j;
        const float p = bf2f(PROJ[(size_t)m * PINP + c]);
        bool ok; int src;
        if (!lat) { if (c < 432) { ok = t >= 1; src = m - 1; } else { ok = t <= T - 2; src = m + 1; } }
        else { const int gc = t & 63, gr = t >> 6;
            if (c < 216) { ok = gc > 0; src = m - 1; } else if (c < 432) { ok = gc < 63; src = m + 1; } else if (c < 648) { ok = gr > 0; src = m - 64; } else { ok = gr < 15; src = m + 64; } }
        const float s = ok ? bf2f(PROJ[(size_t)src * PINP + c]) : 0.f;
        XM[idx] = p + (s - p) * mu[c];
    }
    __syncthreads();
    { const int j = tid >> 5, e = tid & 31; TW[tid] = tanhf(XM[j * RWC + C_RW_WD + e]); SG[tid] = sigmoidf_(XM[j * RWC + C_RW_GD + e]); }
    __syncthreads();
    if (PREP_EN & 1) {
        int c = tid & 255; asm volatile("" : "+v"(c));
        const int half = tid >> 8, h = c >> 6;
        bf16* oR = WSP(bf16, WS_RW_R); bf16* oKK = WSP(bf16, WS_RW_KK); bf16* oV = WSP(bf16, WS_RW_V); bf16* oKD = WSP(bf16, WS_RW_KD); bf16* oB = WSP(bf16, WS_RW_B);
        bf16* oG = WSP(bf16, WS_RW_G); bf16* oE = WSP(bf16, WS_RW_E); float* oBON = WSP(float, WS_RW_BON);
        {
            float w2r[2][16], a2r[2][16];
#pragma unroll
            for (int d = 0; d < 2; ++d)
#pragma unroll
                for (int jj = 0; jj < 16; ++jj) { w2r[d][jj] = INP(I_RWW2)[(((size_t)l * 2 + d) * 16 + jj) * 256 + c]; a2r[d][jj] = INP(I_RWA2)[(((size_t)l * 2 + d) * 16 + jj) * 256 + c]; }
            const float w0_0 = INP(I_RWW0)[(l * 2 + 0) * 256 + c], w0_1 = INP(I_RWW0)[(l * 2 + 1) * 256 + c];
            const float a0_0 = INP(I_RWA0)[(l * 2 + 0) * 256 + c], a0_1 = INP(I_RWA0)[(l * 2 + 1) * 256 + c];
            const float kkw = INP(I_RWKK)[l * 256 + c], ka = INP(I_RWKA)[l * 256 + c], rk = INP(I_RWRK)[l * 256 + c];
#pragma unroll 1
            for (int jt = 0; jt < 8; ++jt) {
                const int j = half * 8 + jt; const size_t m = (size_t)(m0 + j);
                const float r = XM[j * RWC + c], k = XM[j * RWC + 256 + c], v = XM[j * RWC + 512 + c];
                const float kkr = k * kkw; const float ssq = wave_sum(kkr * kkr); const float kkn = kkr / fmaxf(sqrtf(ssq), 1e-12f);
                float lw0 = 0.f, lw1 = 0.f, la0 = 0.f, la1 = 0.f;
#pragma unroll
                for (int jj = 0; jj < 16; ++jj) { lw0 += TW[j * 32 + jj] * w2r[0][jj]; lw1 += TW[j * 32 + 16 + jj] * w2r[1][jj];
                    la0 += XM[j * RWC + C_RW_AD + jj] * a2r[0][jj]; la1 += XM[j * RWC + C_RW_AD + 16 + jj] * a2r[1][jj]; }
                const float e0 = 0.6065306597126334f * sigmoidf_(w0_0 + lw0), e1 = 0.6065306597126334f * sigmoidf_(w0_1 + lw1);
                const float a0 = sigmoidf_(a0_0 + la0), a1 = sigmoidf_(a0_1 + la1);
                const float kd0 = k * (1.f + (a0 - 1.f) * ka), kd1 = k * (1.f + (a1 - 1.f) * ka);
                const float bon = wave_sum(r * (kd0 + kd1) * rk);
                if (lane == 0) oBON[m * 4 + h] = bon;
                const size_t o = m * 256 + c, o1 = ((size_t)MT + m) * 256 + c;
                oR[o] = (bf16)f2bf(r); oKK[o] = (bf16)f2bf(kkn); oV[o] = (bf16)f2bf(v);
                oKD[o] = (bf16)f2bf(kd0); oKD[o1] = (bf16)f2bf(kd1); oB[o] = (bf16)f2bf(kkn * a0); oB[o1] = (bf16)f2bf(kkn * a1);
                oE[o] = (bf16)f2bf(e0); oE[o1] = (bf16)f2bf(e1);
            }
        }
        {
            float g2r[32];
#pragma unroll
            for (int jj = 0; jj < 32; ++jj) g2r[jj] = INP(I_RWG2)[((size_t)l * 32 + jj) * 256 + c];
#pragma unroll 1
            for (int jt = 0; jt < 8; ++jt) {
                const int j = half * 8 + jt; float g = 0.f;
#pragma unroll
                for (int jj = 0; jj < 32; ++jj) g += SG[j * 32 + jj] * g2r[jj];
                oG[(size_t)(m0 + j) * 256 + c] = (bf16)f2bf(g);
            }
        }
    }
    if (PREP_EN & 2) {
        const bf16* base = PROJ + (size_t)ms * PINP + C_SS_XBC;
#pragma unroll 1
        for (int rep = 0; rep < 2; ++rep) {
            const int c = tid + 512 * rep; if (c >= 768) break;
            float w[4], y[16];
#pragma unroll
            for (int j = 0; j < 4; ++j) w[j] = INP(I_SSCW)[((size_t)l * 4 + j) * 768 + c];
            conv16(base + c, t0, T, w, INP(I_SSCB)[l * 768 + c], y);
            bf16* dst = (c < 256 ? WSP(bf16, WS_SS_X) : (c < 512 ? WSP(bf16, WS_SS_B) : WSP(bf16, WS_SS_C))) + (c & 255);
#pragma unroll
            for (int j = 0; j < 16; ++j) dst[(size_t)(m0 + j) * 256] = (bf16)f2bf(siluf_(y[j]));
        }
        if (tid < 128) {
            const int j = tid >> 3, d = (tid >> 2) & 1, h = tid & 3; const size_t m = (size_t)(m0 + j);
            const float dtr = bf2f(PROJ[m * PINP + C_SS_DT + d * 4 + h]);
            const float dt = softplusf_(dtr + INP(I_SSDTB)[(l * 2 + d) * 4 + h]);
            const float an = -expf(INP(I_SSALOG)[(l * 2 + d) * 4 + h]);
            WSP(float, WS_SS_DT)[((size_t)d * MT + m) * 4 + h] = dt; WSP(float, WS_SS_DEC)[((size_t)d * MT + m) * 4 + h] = expf(dt * an);
        }
    }
    if ((PREP_EN & 4) && tid < 256) {
        const int c = tid; float w[4], y[16];
#pragma unroll
        for (int j = 0; j < 4; ++j) w[j] = INP(I_LRCW)[((size_t)l * 4 + j) * 256 + c];
        conv16(PROJ + (size_t)ms * PINP + C_LR_X + c, t0, T, w, INP(I_LRCB)[l * 256 + c], y);
#pragma unroll
        for (int j = 0; j < 16; ++j) { XCf[j * 256 + c] = y[j]; XCb[j * 264 + c] = (bf16)f2bf(y[j]); }
    }
    __syncthreads();
    if (PREP_EN & 8) {
        const int d = C.wave >> 2, h = C.wave & 3, fr = lane & 15, fq = lane >> 4;
        f32x4 acc[2][4];
#pragma unroll
        for (int g = 0; g < 2; ++g)
#pragma unroll
            for (int nt = 0; nt < 4; ++nt) acc[g][nt] = (f32x4){0.f, 0.f, 0.f, 0.f};
        const bf16* WLR = WSP(const bf16, WS_WLR);
#pragma unroll
        for (int ks = 0; ks < 2; ++ks) {
            const bf16x8 A = *(const LAS bf16x8*)(XCb + fr * 264 + h * 64 + ks * 32 + 8 * fq);
#pragma unroll
            for (int g = 0; g < 2; ++g)
#pragma unroll
                for (int nt = 0; nt < 4; ++nt) {
                    const bf16x8 B = *(const bf16x8*)(WLR + ((((size_t)(l * 2 + d) * 2 + g) * 4 + h) * 64 + nt * 16 + fr) * 64 + ks * 32 + 8 * fq);
                    acc[g][nt] = __builtin_amdgcn_mfma_f32_16x16x32_bf16(A, B, acc[g][nt], 0, 0, 0);
                }
        }
        bf16* oLA = WSP(bf16, WS_LR_LA); bf16* oLB = WSP(bf16, WS_LR_B);
#pragma unroll
        for (int nt = 0; nt < 4; ++nt) {
            const int c = h * 64 + nt * 16 + fr;
            const float ba = INP(I_LRBA)[(l * 2 + d) * 256 + c], bx = INP(I_LRBX)[(l * 2 + d) * 256 + c];
            const float sp = softplusf_(-INP(I_LRLAM)[(l * 2 + d) * 256 + c]);
#pragma unroll
            for (int rg = 0; rg < 4; ++rg) {
                const int j = fq * 4 + rg;
                const float r = sigmoidf_(acc[0][nt][rg] + ba), ig = sigmoidf_(acc[1][nt][rg] + bx);
                const float la = -8.f * r * sp;
                const float bq = sqrtf(fmaxf(-expm1f(2.f * la), 0.f)) * (ig * XCf[j * 256 + c]);
                const size_t o = ((size_t)d * MT + m0 + j) * 256 + c;
                oLA[o] = (bf16)f2bf(la); oLB[o] = (bf16)f2bf(bq);
            }
        }
    }
    __syncthreads();
}

constexpr int SC_Y = 49152;
__device__ __forceinline__ v4u ld16(const bf16* p) { return *(const GAS v4u*)p; }
#define STEP_TOKEN(cc, s) (d ? (T - 1 - ((cc) * 32 + (s))) : ((cc) * 32 + (s)))

__device__ __forceinline__ void flush_y(const Ctx& C, bf16* ydst  , int cc, int d, int T) {
    const LAS float* Y = (const LAS float*)(C.lds + SC_Y);
    const int s = C.tid >> 4, pr = C.tid & 15; const int t = STEP_TOKEN(cc, s);
    *(GAS unsigned*)(ydst + (size_t)t * 256 + 2 * pr) = pk2(Y[s * 32 + 2 * pr], Y[s * 32 + 2 * pr + 1]);
}

__device__ __forceinline__ void scan_rwkv(const Ctx& C, int l, int lat, int b, int d, int h, int rb) {
    const int tid = C.tid, row = tid >> 4, q = tid & 15;
    const int T = lat ? TL : TC, ms = lat ? MC + b * TL : b * TC, nch = T / 32;
    LAS float* LW = (LAS float*)C.lds; LAS float* LKK = LW + 2048; LAS float* LB_ = LW + 4096; LAS float* LKD = LW + 6144; LAS float* LR = LW + 8192; LAS float* LV = LW + 10240; LAS float* LY = (LAS float*)(C.lds + SC_Y);
    const int hi = tid >> 8, p = tid & 255, ps = p >> 3, pp = p & 7;
    const size_t doff = (size_t)d * MT * 256;
    const bf16* a0 = (hi ? WSP(const bf16, WS_RW_KK) : WSP(const bf16, WS_RW_E) + doff) + (size_t)ms * 256 + h * 64 + pp * 8;
    const bf16* a1 = (hi ? WSP(const bf16, WS_RW_KD) + doff : WSP(const bf16, WS_RW_B) + doff) + (size_t)ms * 256 + h * 64 + pp * 8;
    const bf16* a2 = hi ? WSP(const bf16, WS_RW_V) + (size_t)ms * 256 + h * 64 + rb * 32 + (p & 3) * 8 : WSP(const bf16, WS_RW_R) + (size_t)ms * 256 + h * 64 + pp * 8;
    const int s2 = hi ? (p >> 2) : ps; const bool do2 = !hi || p < 128;
    LAS float* d0 = (hi ? LKK : LW) + ps * 64 + pp * 8; LAS float* d1 = (hi ? LKD : LB_) + ps * 64 + pp * 8; LAS float* d2 = hi ? LV + (p >> 2) * 32 + (p & 3) * 8 : LR + ps * 64 + pp * 8;
    float S0, S1, S2, S3;
    const int v = rb * 32 + row;
    if (lat) { const f4 s = *(const f4*)(INP(I_SRW) + ((((size_t)(b * 4 + l) * 2 + d) * 4 + h) * 64 + v) * 64 + 4 * q); S0 = s.x; S1 = s.y; S2 = s.z; S3 = s.w; }
    else { S0 = S1 = S2 = S3 = 0.f; }
    bf16* ydst = WSP(bf16, WS_YS) + ((size_t)(0 * 2 + d) * MT + ms) * 256 + h * 64 + rb * 32;
    v4u pf0, pf1, pf2 = (v4u){0u, 0u, 0u, 0u};
    { pf0 = ld16(a0 + (size_t)STEP_TOKEN(0, ps) * 256); pf1 = ld16(a1 + (size_t)STEP_TOKEN(0, ps) * 256); if (do2) pf2 = ld16(a2 + (size_t)STEP_TOKEN(0, s2) * 256); }
#pragma unroll 1
    for (int cc = 0; cc < nch; ++cc) {
        { float o[8]; cvt8(pf0, o); if (!hi) {
#pragma unroll
                for (int i = 0; i < 8; ++i) o[i] = __expf(-o[i]); }
            st8(d0, o); cvt8(pf1, o); st8(d1, o); if (do2) { cvt8(pf2, o); st8(d2, o); } }
        __syncthreads();
        if (cc + 1 < nch) { pf0 = ld16(a0 + (size_t)STEP_TOKEN(cc + 1, ps) * 256); pf1 = ld16(a1 + (size_t)STEP_TOKEN(cc + 1, ps) * 256); if (do2) pf2 = ld16(a2 + (size_t)STEP_TOKEN(cc + 1, s2) * 256); }
#pragma unroll 4
        for (int s = 0; s < 32; ++s) {
            const f4 w = *(const LAS f4*)(LW + s * 64 + 4 * q), kk = *(const LAS f4*)(LKK + s * 64 + 4 * q), bv = *(const LAS f4*)(LB_ + s * 64 + 4 * q),
                     kd = *(const LAS f4*)(LKD + s * 64 + 4 * q), r = *(const LAS f4*)(LR + s * 64 + 4 * q);
            const float vv = LV[s * 32 + row];
            const float sa = -sum16((S0 * kk.x + S1 * kk.y) + (S2 * kk.z + S3 * kk.w));
            S0 = S0 * w.x + (sa * bv.x + vv * kd.x); S1 = S1 * w.y + (sa * bv.y + vv * kd.y); S2 = S2 * w.z + (sa * bv.z + vv * kd.z); S3 = S3 * w.w + (sa * bv.w + vv * kd.w);
            const float yp = sum16((S0 * r.x + S1 * r.y) + (S2 * r.z + S3 * r.w));
            if (q == 0) LY[s * 32 + row] = yp;
        }
        __syncthreads();
        flush_y(C, ydst, cc, d, T);
    }
    if (!lat) *(f4*)(C.out + O_SRW + ((((size_t)(b * 4 + l) * 2 + d) * 4 + h) * 64 + v) * 64 + 4 * q) = (f4){S0, S1, S2, S3};
}

__device__ __forceinline__ void scan_hgrn(const Ctx& C, int l, int lat, int b, int d, int h, int vb) {
    const int tid = C.tid, row = tid >> 4, q = tid & 15;
    const int T = lat ? TL : TC, ms = lat ? MC + b * TL : b * TC, nch = T / 32;
    LAS float* LQ = (LAS float*)C.lds; LAS float* LF = LQ + 2048; LAS float* LKD = LQ + 4096; LAS float* LI = LQ + 6144; LAS float* LY = (LAS float*)(C.lds + SC_Y);
    const int hi = tid >> 8, p = tid & 255, ps = p >> 3, pp = p & 7;
    const bf16* PROJ = WSP(const bf16, WS_PROJ);
    const bf16* a0 = PROJ + (size_t)ms * PINP + (hi ? C_HG_F + d * 256 : C_HG_Q) + h * 64 + pp * 8;
    const bf16* a2 = PROJ + (size_t)ms * PINP + C_HG_I + h * 64 + vb * 32 + (p & 3) * 8;
    const bool do2 = !hi && p < 128; const int s2 = p >> 2;
    float lb[8];
#pragma unroll
    for (int i = 0; i < 8; ++i) lb[i] = WSP(const float, WS_LB)[(l * 2 + d) * 256 + h * 64 + pp * 8 + i];
    const int v = vb * 32 + row;
    float S0, S1, S2, S3;
    if (lat) { const float* sp = INP(I_SHG) + ((((size_t)(b * 4 + l) * 2 + d) * 4 + h) * 64 + 4 * q) * 64 + v; S0 = sp[0]; S1 = sp[64]; S2 = sp[128]; S3 = sp[192]; }
    else { S0 = S1 = S2 = S3 = 0.f; }
    bf16* ydst = WSP(bf16, WS_YS) + ((size_t)(1 * 2 + d) * MT + ms) * 256 + h * 64 + vb * 32;
    v4u pf0, pf2 = (v4u){0u, 0u, 0u, 0u};
    { pf0 = ld16(a0 + (size_t)STEP_TOKEN(0, ps) * PINP); if (do2) pf2 = ld16(a2 + (size_t)STEP_TOKEN(0, s2) * PINP); }
#pragma unroll 1
    for (int cc = 0; cc < nch; ++cc) {
        { float o[8]; cvt8(pf0, o);
            if (!hi) {
#pragma unroll
                for (int i = 0; i < 8; ++i) o[i] = siluf_(o[i]);
                st8(LQ + ps * 64 + pp * 8, o);
            } else { float kd[8];
#pragma unroll
                for (int i = 0; i < 8; ++i) { const float sg = sigmoidf_(o[i]); kd[i] = (1.f - lb[i]) * (1.f - sg); o[i] = lb[i] + (1.f - lb[i]) * sg; }
                st8(LF + ps * 64 + pp * 8, o); st8(LKD + ps * 64 + pp * 8, kd); }
            if (do2) { cvt8(pf2, o); st8(LI + s2 * 32 + (p & 3) * 8, o); } }
        __syncthreads();
        if (cc + 1 < nch) { pf0 = ld16(a0 + (size_t)STEP_TOKEN(cc + 1, ps) * PINP); if (do2) pf2 = ld16(a2 + (size_t)STEP_TOKEN(cc + 1, s2) * PINP); }
#pragma unroll 4
        for (int s = 0; s < 32; ++s) {
            const f4 f = *(const LAS f4*)(LF + s * 64 + 4 * q), kd = *(const LAS f4*)(LKD + s * 64 + 4 * q), qq = *(const LAS f4*)(LQ + s * 64 + 4 * q);
            const float iv = LI[s * 32 + row];
            S0 = f.x * S0 + kd.x * iv; S1 = f.y * S1 + kd.y * iv; S2 = f.z * S2 + kd.z * iv; S3 = f.w * S3 + kd.w * iv;
            const float o = sum16((S0 * qq.x + S1 * qq.y) + (S2 * qq.z + S3 * qq.w));
            if (q == 0) LY[s * 32 + row] = o;
        }
        __syncthreads();
        flush_y(C, ydst, cc, d, T);
    }
    if (!lat) { float* sp = C.out + O_SHG + ((((size_t)(b * 4 + l) * 2 + d) * 4 + h) * 64 + 4 * q) * 64 + v; sp[0] = S0; sp[64] = S1; sp[128] = S2; sp[192] = S3; }
}

__device__ __forceinline__ void scan_ssd(const Ctx& C, int l, int lat, int b, int d, int h, int pb) {
    const int tid = C.tid, row = tid >> 4, q = tid & 15;
    const int T = lat ? TL : TC, ms = lat ? MC + b * TL : b * TC, nch = T / 32;
    LAS float* LBm = (LAS float*)C.lds; LAS float* LCm = LBm + 4096; LAS float* LX = LBm + 8192; LAS float* LDT = LBm + 9216; LAS float* LDEC = LBm + 9248; LAS float* LY = (LAS float*)(C.lds + SC_Y);
    const int ps = tid >> 4, pp = tid & 15, g = h >> 1;
    const bf16* aB = WSP(const bf16, WS_SS_B) + (size_t)ms * 256 + g * 128 + pp * 8;
    const bf16* aC = WSP(const bf16, WS_SS_C) + (size_t)ms * 256 + g * 128 + pp * 8;
    const bf16* aX = WSP(const bf16, WS_SS_X) + (size_t)ms * 256 + h * 64 + pb * 32 + (tid & 3) * 8;
    const float* aDT = WSP(const float, WS_SS_DT) + ((size_t)d * MT + ms) * 4 + h; const float* aDEC = WSP(const float, WS_SS_DEC) + ((size_t)d * MT + ms) * 4 + h;
    const bool doX = tid < 128, doD = tid >= 128 && tid < 160; const int sX = tid >> 2, sD = tid - 128;
    const int pr = pb * 32 + row;
    float S[8];
    if (lat) { const float* sp = INP(I_SSS) + ((((size_t)(b * 4 + l) * 2 + d) * 4 + h) * 64 + pr) * 128 + 8 * q; const f4 x = *(const f4*)sp, y = *(const f4*)(sp + 4); S[0] = x.x; S[1] = x.y; S[2] = x.z; S[3] = x.w; S[4] = y.x; S[5] = y.y; S[6] = y.z; S[7] = y.w; }
    else {
#pragma unroll
        for (int i = 0; i < 8; ++i) S[i] = 0.f; }
    bf16* ydst = WSP(bf16, WS_YS) + ((size_t)(2 * 2 + d) * MT + ms) * 256 + h * 64 + pb * 32;
    v4u pfB, pfC, pfX = (v4u){0u, 0u, 0u, 0u}; float pfDT = 0.f, pfDEC = 0.f;
    { pfB = ld16(aB + (size_t)STEP_TOKEN(0, ps) * 256); pfC = ld16(aC + (size_t)STEP_TOKEN(0, ps) * 256); if (doX) pfX = ld16(aX + (size_t)STEP_TOKEN(0, sX) * 256);
      if (doD) { pfDT = aDT[(size_t)STEP_TOKEN(0, sD) * 4]; pfDEC = aDEC[(size_t)STEP_TOKEN(0, sD) * 4]; } }
#pragma unroll 1
    for (int cc = 0; cc < nch; ++cc) {
        { float o[8]; cvt8(pfB, o); st8(LBm + ps * 128 + pp * 8, o); cvt8(pfC, o); st8(LCm + ps * 128 + pp * 8, o);
          if (doX) { cvt8(pfX, o); st8(LX + sX * 32 + (tid & 3) * 8, o); }
          if (doD) { LDT[sD] = pfDT; LDEC[sD] = pfDEC; } }
        __syncthreads();
        if (cc + 1 < nch) { pfB = ld16(aB + (size_t)STEP_TOKEN(cc + 1, ps) * 256); pfC = ld16(aC + (size_t)STEP_TOKEN(cc + 1, ps) * 256); if (doX) pfX = ld16(aX + (size_t)STEP_TOKEN(cc + 1, sX) * 256);
            if (doD) { pfDT = aDT[(size_t)STEP_TOKEN(cc + 1, sD) * 4]; pfDEC = aDEC[(size_t)STEP_TOKEN(cc + 1, sD) * 4]; } }
#pragma unroll 2
        for (int s = 0; s < 32; ++s) {
            const f4 b0 = *(const LAS f4*)(LBm + s * 128 + 8 * q), b1 = *(const LAS f4*)(LBm + s * 128 + 8 * q + 4), c0 = *(const LAS f4*)(LCm + s * 128 + 8 * q), c1 = *(const LAS f4*)(LCm + s * 128 + 8 * q + 4);
            const float xdt = LX[s * 32 + row] * LDT[s], dec = LDEC[s];
            S[0] = dec * S[0] + xdt * b0.x; S[1] = dec * S[1] + xdt * b0.y; S[2] = dec * S[2] + xdt * b0.z; S[3] = dec * S[3] + xdt * b0.w;
            S[4] = dec * S[4] + xdt * b1.x; S[5] = dec * S[5] + xdt * b1.y; S[6] = dec * S[6] + xdt * b1.z; S[7] = dec * S[7] + xdt * b1.w;
            const float y = sum16(((S[0] * c0.x + S[1] * c0.y) + (S[2] * c0.z + S[3] * c0.w)) + ((S[4] * c1.x + S[5] * c1.y) + (S[6] * c1.z + S[7] * c1.w)));
            if (q == 0) LY[s * 32 + row] = y;
        }
        __syncthreads();
        flush_y(C, ydst, cc, d, T);
    }
    if (!lat) { float* sp = C.out + O_SSS + ((((size_t)(b * 4 + l) * 2 + d) * 4 + h) * 64 + pr) * 128 + 8 * q; *(f4*)sp = (f4){S[0], S[1], S[2], S[3]}; *(f4*)(sp + 4) = (f4){S[4], S[5], S[6], S[7]}; }
}

__device__ __forceinline__ void scan_lru(const Ctx& C, int l, int lat, int b) {
    const int d = C.tid >> 8, c = C.tid & 255;
    const int T = lat ? TL : TC, ms = lat ? MC + b * TL : b * TC;
    const bf16* aLA = WSP(const bf16, WS_LR_LA) + ((size_t)d * MT + ms) * 256 + c; const bf16* aLB = WSP(const bf16, WS_LR_B) + ((size_t)d * MT + ms) * 256 + c;
    bf16* yd = WSP(bf16, WS_YS) + ((size_t)(3 * 2 + d) * MT + ms) * 256 + c;
    float hs = lat ? INP(I_SLR)[((size_t)(b * 4 + l) * 2 + d) * 256 + c] : 0.f;
#pragma unroll 1
    for (int s0 = 0; s0 < T; s0 += 8) {
        float la[8], bb[8];
#pragma unroll
        for (int i = 0; i < 8; ++i) { const int t = d ? T - 1 - (s0 + i) : s0 + i; la[i] = bf2f(aLA[(size_t)t * 256]); bb[i] = bf2f(aLB[(size_t)t * 256]); }
#pragma unroll
        for (int i = 0; i < 8; ++i) { const int t = d ? T - 1 - (s0 + i) : s0 + i; hs = __expf(la[i]) * hs + bb[i]; yd[(size_t)t * 256] = (bf16)f2bf(hs); }
    }
    if (!lat) C.out[O_SLR + ((size_t)(b * 4 + l) * 2 + d) * 256 + c] = hs;
}

__device__ __forceinline__ void scan_dispatch(const Ctx& C, int l, int lat, int jid) {
    const int per = lat ? 64 : 512; const int mixer = jid / per, r = jid - mixer * per;
    const int b = r >> 4, d = (r >> 3) & 1, h = (r >> 1) & 3, rb = r & 1;
    if (mixer == 0) scan_rwkv(C, l, lat, b, d, h, rb); else if (mixer == 1) scan_hgrn(C, l, lat, b, d, h, rb); else scan_ssd(C, l, lat, b, d, h, rb);
}
__device__ __forceinline__ void phase_scans(const Ctx& C, int l) {
    const int w = C.wg;
    if (C.G == 256) {
#pragma unroll 1
        for (int i = 0; i < 10; ++i) {
            int kind = 0, id = 0;
            if (w < 192) { if (i == 0) { kind = 1; id = w; } else if (i <= 5) { kind = 2; id = 5 * w + i - 1; } }
            else { const int x = w - 192; if (i == 0) { kind = x < 36 ? 3 : 0; id = x; } else { kind = 2; id = 960 + 9 * x + i - 1; } }
            asm volatile("" : "+s"(kind), "+s"(id));
            if (kind == 1 || kind == 2) scan_dispatch(C, l, kind == 1 ? 1 : 0, id);
            else if (kind == 3) scan_lru(C, l, id >= 32 ? 1 : 0, id >= 32 ? id - 32 : id);
        }
    } else {
#pragma unroll 1
        for (int j = w; j < 192 + 1536 + 36; j += C.G) {
            int kind = j < 192 ? 1 : (j < 1728 ? 2 : 3), id = j < 192 ? j : (j < 1728 ? j - 192 : j - 1728);
            asm volatile("" : "+s"(kind), "+s"(id));
            if (kind == 1 || kind == 2) scan_dispatch(C, l, kind == 1 ? 1 : 0, id);
            else scan_lru(C, l, id >= 32 ? 1 : 0, id >= 32 ? id - 32 : id);
        }
    }
}

__device__ __forceinline__ void ld4bf(const bf16* p, float (&o)[4]) { const unsigned long long w = *(const GAS unsigned long long*)p; o[0] = bflo((unsigned)w); o[1] = bfhi((unsigned)w); o[2] = bflo((unsigned)(w >> 32)); o[3] = bfhi((unsigned)(w >> 32)); }
__device__ __forceinline__ void st4bf(bf16* p, const float (&o)[4]) { *(GAS unsigned long long*)p = (unsigned long long)pk2(o[0], o[1]) | ((unsigned long long)pk2(o[2], o[3]) << 32); }
__device__ __forceinline__ void phase_post(const Ctx& C, int l) {
    const int gw = C.wg * NWAVES + C.wave, NGW = C.G * NWAVES, lane = C.lane, c4 = 4 * lane, h = lane >> 4;
    const bf16* YS = WSP(const bf16, WS_YS); const bf16* PROJ = WSP(const bf16, WS_PROJ); bf16* MIX = WSP(bf16, WS_MIX);
    const f4 lnw = *(const f4*)(INP(I_RWLNW) + l * 256 + c4), lnb = *(const f4*)(INP(I_RWLNB) + l * 256 + c4), hgn = *(const f4*)(INP(I_HGNORM) + l * 256 + c4), ssn = *(const f4*)(INP(I_SSNORM) + l * 256 + c4);
    const float Dh = INP(I_SSD)[l * 4 + h];
    const size_t YA = (size_t)MT * 256;
    for (int m = gw; m < MT; m += NGW) {
        const size_t mo = (size_t)m * 256 + c4; float a[4], b[4], o[4];
        { ld4bf(YS + 0 * YA + mo, a); ld4bf(YS + 1 * YA + mo, b); float y[4], s = 0.f;
#pragma unroll
          for (int i = 0; i < 4; ++i) { y[i] = a[i] + b[i]; s += y[i]; }
          const float mean = sum16(s) * (1.f / 64.f); float qv = 0.f;
#pragma unroll
          for (int i = 0; i < 4; ++i) { y[i] -= mean; qv += y[i] * y[i]; }
          const float rs = rsqrtf(sum16(qv) * (1.f / 64.f) + 64e-5f);
          float vv[4], gg[4]; ld4bf(WSP(const bf16, WS_RW_V) + mo, vv); ld4bf(WSP(const bf16, WS_RW_G) + mo, gg);
          const float bon = WSP(const float, WS_RW_BON)[(size_t)m * 4 + h];
#pragma unroll
          for (int i = 0; i < 4; ++i) o[i] = (y[i] * rs * lnw[i] + lnb[i] + bon * vv[i]) * gg[i];
          st4bf(MIX + (size_t)m * DM + c4, o); }
        { ld4bf(YS + 2 * YA + mo, a); ld4bf(YS + 3 * YA + mo, b); float y[4], s = 0.f;
#pragma unroll
          for (int i = 0; i < 4; ++i) { y[i] = a[i] + b[i]; s += y[i] * y[i]; }
          const float rs = rsqrtf(wave_sum(s) * (1.f / 256.f) + 1e-6f);
          float gp[4]; ld4bf(PROJ + (size_t)m * PINP + C_HG_G + c4, gp);
#pragma unroll
          for (int i = 0; i < 4; ++i) o[i] = y[i] * rs * hgn[i] * siluf_(gp[i]);
          st4bf(MIX + (size_t)m * DM + 256 + c4, o); }
        { ld4bf(YS + 4 * YA + mo, a); ld4bf(YS + 5 * YA + mo, b); float xx[4], zz[4], y[4], s = 0.f; ld4bf(WSP(const bf16, WS_SS_X) + mo, xx); ld4bf(PROJ + (size_t)m * PINP + C_SS_Z + c4, zz);
#pragma unroll
          for (int i = 0; i < 4; ++i) { y[i] = (a[i] + b[i] + Dh * xx[i]) * siluf_(zz[i]); s += y[i] * y[i]; }
          const float rs = rsqrtf(wave_sum(s) * (1.f / 256.f) + 1e-6f);
#pragma unroll
          for (int i = 0; i < 4; ++i) o[i] = y[i] * rs * ssn[i];
          st4bf(MIX + (size_t)m * DM + 512 + c4, o); }
        { ld4bf(YS + 6 * YA + mo, a); ld4bf(YS + 7 * YA + mo, b); float yb[4]; ld4bf(PROJ + (size_t)m * PINP + C_LR_Y + c4, yb);
#pragma unroll
          for (int i = 0; i < 4; ++i) o[i] = (a[i] + b[i]) * gelu_tanh(yb[i]);
          st4bf(MIX + (size_t)m * DM + 768 + c4, o); }
    }
}

struct Args { const float* in[N_IN]; float* out; unsigned char* ws; int ph_lo, ph_hi; };
constexpr int N_PHASES = 2 + 9 * DEPTH;
#ifndef MKEN
#define MKEN 0xFFFF
#endif
#define EN(x) ((MKEN >> (x)) & 1)
__global__ void __launch_bounds__(NWAVES * 64, 2) mk_fwd(Args args) {
    extern __shared__ __attribute__((aligned(16))) unsigned char lds_raw[];
    Ctx C;
    C.out = args.out; C.ws = args.ws;
    C.lds = (LAS unsigned char*)lds_raw;
    C.tid = threadIdx.x; C.lane = C.tid & 63; C.wave = __builtin_amdgcn_readfirstlane(C.tid >> 6);
    C.G = gridDim.x; C.wg = blockIdx.x;
    volatile LAS unsigned* MISC = (volatile LAS unsigned*)(C.lds + MISC_OFF);
    for (int u = C.tid; u < (LDS_BYTES - LDSCTL_OFF) / 4; u += NWAVES * 64) ((LAS unsigned*)(C.lds + LDSCTL_OFF))[u] = 0u;
    __syncthreads();
    if (C.tid == 0) {
#pragma unroll
        for (int i = 0; i < N_IN; ++i) *(LAS unsigned long long*)(C.lds + PTAB_OFF + 8 * i) = (unsigned long long)args.in[i];
    }
    __syncthreads();
    const int lo = args.ph_lo, hi = args.ph_hi;
    XcdBarrier bar; bar.bar = (unsigned*)(C.ws + WS_CTL) + CW_BAR; bar.x = 0; bar.st = nullptr;
    if (hi - lo > 1) bar = xcd_barrier_post((unsigned*)(C.ws + WS_CTL) + CW_BAR, MISC + 8);
#define IN(k) (lo <= (k) && (k) < hi)
#define SEAM(k) do { if (IN(k) && IN((k) + 1)) xcd_barrier(bar); RELAUNDER(); } while (0)
#define RELAUNDER() do { int t_ = threadIdx.x; asm volatile("" : "+v"(t_)); C.tid = t_; C.lane = t_ & 63; C.wave = __builtin_amdgcn_readfirstlane(t_ >> 6); } while (0)
    if (EN(0) && IN(0)) { p0_prologue(C); } SEAM(0);
    if (EN(1) && IN(1)) { phase_norm_in(C); } SEAM(1);
#pragma unroll 1
    for (int l = 0; l < DEPTH; ++l) {
        const int p0 = 2 + 9 * l;
        if (EN(2) && IN(p0 + 0)) {
            pg8::Gemm g{WSP(const bf16, WS_H), WSP(const bf16, WS_WIN) + (size_t)l * PINP * DM, MT, PINP, DM}; pg8::StaticOrder S; S.init(MT, PINP, C.G, C.wg);
            pg8::EpiBf16<0> E{WSP(bf16, WS_PROJ), PINP};
            pg8::gemm_phase<pg8::EpiBf16<0>, pg8::StaticOrder, PG8_ALIGN, PG8_SP2>(C.lds, g, S, E);
        } SEAM(p0 + 0);
        if (EN(3) && IN(p0 + 1)) { for (int t = C.wg; t < MT / 16; t += C.G) prep_tile(C, l, t); } SEAM(p0 + 1);
        if (EN(4) && IN(p0 + 2)) { phase_scans(C, l); } SEAM(p0 + 2);
        if (EN(5) && IN(p0 + 3)) { phase_post(C, l); } SEAM(p0 + 3);
        if (EN(6) && IN(p0 + 4)) {
            pg8::Gemm g{WSP(const bf16, WS_MIX), WSP(const bf16, WS_WOUT) + (size_t)l * DM * DM, MT, DM, DM}; pg8::StaticOrder S; S.init(MT, DM, C.G, C.wg);
            pg8::EpiF32 E{WSP(float, WS_GO), DM};
            pg8::gemm_phase<pg8::EpiF32, pg8::StaticOrder, PG8_ALIGN, PG8_SP2>(C.lds, g, S, E);
        } SEAM(p0 + 4);
        if (EN(7) && IN(p0 + 5)) { phase_norm_res(C, l, 0); } SEAM(p0 + 5);
        if (EN(8) && IN(p0 + 6)) {
            pg8::Gemm g{WSP(const bf16, WS_H), WSP(const bf16, WS_W1) + (size_t)l * FFD * DM, MT, FFD, DM}; pg8::StaticOrder S; S.init(MT, FFD, C.G, C.wg);
            pg8::EpiBf16<2> E{WSP(bf16, WS_U), FFD};
            pg8::gemm_phase<pg8::EpiBf16<2>, pg8::StaticOrder, PG8_ALIGN, PG8_SP2>(C.lds, g, S, E);
        } SEAM(p0 + 6);
        if (EN(9) && IN(p0 + 7)) {
            pg8::Gemm g{WSP(const bf16, WS_U), WSP(const bf16, WS_W2) + (size_t)l * DM * FFD, MT, DM, FFD}; pg8::StaticOrder S; S.init(MT, DM, C.G, C.wg);
            pg8::EpiF32 E{WSP(float, WS_GO), DM};
            pg8::gemm_phase<pg8::EpiF32, pg8::StaticOrder, PG8_ALIGN, PG8_SP2>(C.lds, g, S, E);
        } SEAM(p0 + 7);
        if (EN(10) && IN(p0 + 8)) { phase_norm_res(C, l, 1); } SEAM(p0 + 8);
    }
#undef IN
#undef SEAM
}

extern "C" void kernel_launch(void* const* d_in, const int* in_sizes, int n_in, void* d_out, int out_size, void* d_ws, size_t ws_size, hipStream_t stream) {
    static int grid = 0;
    if (grid == 0) {
        if (n_in != N_IN || (size_t)out_size != O_END || ws_size < WS_END) { fprintf(stderr, "kernel_launch: unexpected shapes: n_in %d out %d ws %zu (need %zu)\n", n_in, out_size, ws_size, (size_t)WS_END); grid = -1; return; }
        int dev = 0, cus = 0, per_cu = 0;
        if (hipGetDevice(&dev) != hipSuccess || hipDeviceGetAttribute(&cus, hipDeviceAttributeMultiprocessorCount, dev) != hipSuccess) { grid = -1; return; }
        if (hipFuncSetAttribute((const void*)mk_fwd, hipFuncAttributeMaxDynamicSharedMemorySize, LDS_BYTES) != hipSuccess) { fprintf(stderr, "kernel_launch: hipFuncSetAttribute failed\n"); grid = -1; return; }
        if (hipOccupancyMaxActiveBlocksPerMultiprocessor(&per_cu, (const void*)mk_fwd, NWAVES * 64, LDS_BYTES) != hipSuccess || per_cu < 1) { fprintf(stderr, "kernel_launch: occupancy query says %d blocks per CU\n", per_cu); (void)hipGetLastError(); grid = -1; return; }
        grid = cus;
    }
    if (grid < 0) return;
    if (hipMemsetAsync((char*)d_ws + WS_CTL, 0, CTL_ZERO_BYTES, stream) != hipSuccess) return;
    Args a{};
    for (int i = 0; i < N_IN; ++i) a.in[i] = (const float*)d_in[i];
    a.out = (float*)d_out; a.ws = (unsigned char*)d_ws;
#if MK_SINGLE
    a.ph_lo = 0; a.ph_hi = N_PHASES;
    void* kargs[] = {&a};
    hipError_t e = hipLaunchCooperativeKernel((const void*)mk_fwd, dim3(grid), dim3(NWAVES * 64), kargs, LDS_BYTES, stream);
    if (e != hipSuccess) fprintf(stderr, "kernel_launch: cooperative launch failed: %s (grid %d)\n", hipGetErrorString(e), grid);
#else
    for (int p = 0; p < N_PHASES; ++p) { a.ph_lo = p; a.ph_hi = p + 1; hipLaunchKernelGGL(mk_fwd, dim3(grid), dim3(NWAVES * 64), LDS_BYTES, stream, a); }
#endif
}
```

```cpp
#include <hip/hip_runtime.h>
#include <cstdio>
#include <cstdint>
namespace pg8 {
#define PG8_LAS __attribute__((address_space(3)))
typedef unsigned short bf16_t;
typedef short bf16x8 __attribute__((ext_vector_type(8)));
typedef float f32x4 __attribute__((ext_vector_type(4)));
typedef unsigned u32x4 __attribute__((ext_vector_type(4)));
constexpr int BM = 256, BK = 64, HALF = 128, HTB = HALF * BK * 2  , STAGE_BYTES = 8 * HTB, NXCD = 8, WGM = 8;

__host__ __device__ __forceinline__ int lds_byte(int r, int c) { const int st = (r >> 4) * 2 + (c >> 5), rr = r & 15, cc = c & 31, ob = rr * 64 + cc * 2; return st * 1024 + (ob ^ (((ob >> 9) & 1) << 5)); }
__host__ __device__ __forceinline__ void stage_rc(int b, int& R, int& C) { const int st = b / 1024, sb = b % 1024, swz = sb ^ (((sb >> 9) & 1) << 5); R = (st >> 1) * 16 + swz / 64; C = (st & 1) * 32 + (swz % 64) / 2; }
__host__ __device__ __forceinline__ int perm32(int rho) { const int n = rho >> 4, i = rho & 15; return 8 * (i >> 2) + 4 * n + (i & 3); }

struct Unit { int pm, pn; };
struct Gemm { const bf16_t* A; const bf16_t* Bt; int M, N, K; };

struct StaticOrder {
    int nM, nN, nwg, G, c;
    __host__ __device__ void init(int M, int N, int G_, int c_) { nM = M / BM; nN = N / BM; nwg = nM * nN; G = G_; c = c_; }
    __host__ __device__ bool next(int i, Unit& u) const {
        const long L = (long)i * G + c; if (L >= nwg) return false;
        int wgid = (int)L; { const int q = nwg / NXCD, r = nwg % NXCD, xcd = wgid % NXCD, off = wgid / NXCD; wgid = (xcd < r ? xcd * (q + 1) : r * (q + 1) + (xcd - r) * q) + off; }
        const int nig = WGM * nN, gid = wgid / nig, fm = gid * WGM, gsz = (nM - fm) < WGM ? (nM - fm) : WGM;
        u.pm = fm + ((wgid % nig) % gsz); u.pn = (wgid % nig) / gsz; return true;
    }
    __device__ __forceinline__ void a_ready(const Unit&) const {}
    __device__ __forceinline__ void done(const Unit&) const {}
};

__device__ __forceinline__ unsigned cvt_pk_bf16(float lo, float hi) { unsigned r; asm volatile("v_cvt_pk_bf16_f32 %0, %1, %2" : "=v"(r) : "v"(lo), "v"(hi)); return r; }
typedef float f32x2 __attribute__((ext_vector_type(2)));
__device__ __forceinline__ f32x2 gelu_pk(f32x2 v) {
    const f32x2 av = __builtin_elementwise_abs(v), d = av * 0.2316418882f + 1.0f;
    f32x2 t; t.x = __builtin_amdgcn_rcpf(d.x); t.y = __builtin_amdgcn_rcpf(d.y);
    f32x2 q = t * 0.5307027145f + (-0.7265760135f); q = q * t + 0.7107068705f; q = q * t + (-0.142248368f); q = q * t + 0.127414796f; q = q * t;
    const f32x2 s = (v * v) * (-0.72134752044f);
    f32x2 e; e.x = __builtin_amdgcn_exp2f(s.x); e.y = __builtin_amdgcn_exp2f(s.y);
    const f32x2 m = v * (q * e), r = v - m;
    f32x2 o; o.x = v.x < 0.f ? m.x : r.x; o.y = v.y < 0.f ? m.y : r.y; return o;
}

template <int ACT  > struct EpiBf16 {
    static constexpr bool PERM = true, AFTER_DRAIN = false;
    bf16_t* O; int ldc;
    __device__ __forceinline__ void operator()(const f32x4 (&acc)[2][2][4][2], const Unit& u, int wr, int wc, int fr, int fq) const {
        const int row0 = u.pm * BM + wr * 64 + fr; const int col0 = u.pn * BM + wc * 32 + 8 * fq;
#pragma unroll
        for (int ai = 0; ai < 2; ++ai)
#pragma unroll
            for (int m = 0; m < 4; ++m) { bf16_t* rowp = O + (size_t)(row0 + ai * HALF + m * 16) * ldc + col0;
#pragma unroll
                for (int bj = 0; bj < 2; ++bj) { f32x4 v0 = acc[ai][bj][m][0], v1 = acc[ai][bj][m][1];
                    if (ACT == 2) {
#pragma unroll
                        for (int e = 0; e < 4; ++e) { float a = fmaxf(v0[e], 0.f), b = fmaxf(v1[e], 0.f); v0[e] = a * a; v1[e] = b * b; } }
                    u32x4 w; w.x = cvt_pk_bf16(v0[0], v0[1]); w.y = cvt_pk_bf16(v0[2], v0[3]); w.z = cvt_pk_bf16(v1[0], v1[1]); w.w = cvt_pk_bf16(v1[2], v1[3]);
                    *(u32x4*)(rowp + bj * HALF) = w; } }
    }
};
struct EpiF32 {
    static constexpr bool PERM = false, AFTER_DRAIN = false;
    float* O; int ldc;
    __device__ __forceinline__ void operator()(const f32x4 (&acc)[2][2][4][2], const Unit& u, int wr, int wc, int fr, int fq) const {
        const int col0 = u.pn * BM + wc * 32 + 4 * fq;
#pragma unroll
        for (int ai = 0; ai < 2; ++ai)
#pragma unroll
            for (int m = 0; m < 4; ++m) { const size_t off = (size_t)(u.pm * BM + ai * HALF + wr * 64 + m * 16 + fr) * ldc + col0;
#pragma unroll
                for (int bj = 0; bj < 2; ++bj)
#pragma unroll
                    for (int n = 0; n < 2; ++n) *(f32x4*)(O + off + bj * HALF + n * 16) = acc[ai][bj][m][n]; }
    }
};
template <class Epi, class Sched, bool ALIGN_EPI = false, bool SP2 = false>
__device__ __forceinline__ void gemm_phase(PG8_LAS unsigned char* lds, const Gemm g, const Sched& S, const Epi& E) {
    int tid_ = threadIdx.x; asm volatile("" : "+v"(tid_));
    const int tid = tid_, wid = __builtin_amdgcn_readfirstlane(tid >> 6), lane = tid & 63, wr = wid >> 2, wc = wid & 3, fr = lane & 15, fq = lane >> 4;
    const int K = g.K, nt = K / BK;
    unsigned voffA[2], voffB[2];
#pragma unroll
    for (int i = 0; i < 2; ++i) { int R, C; stage_rc(tid * 16 + i * 8192, R, C); const int Rb = Epi::PERM ? ((R & ~31) + perm32(R & 31)) : R;
        voffA[i] = (unsigned)(R * K + C) * 2u; voffB[i] = (unsigned)(Rb * K + C) * 2u; }
    const size_t kstep = (size_t)(BK * 2);
    const size_t hstep = (size_t)HALF * K * 2;
    const size_t tstep = 2 * hstep;
    const unsigned ldsw = (unsigned)wid * 1024u;
    const int aoff = lds_byte(wr * 64 + fr, fq * 8), boff = lds_byte(wc * 32 + fr, fq * 8);
#define PG8_SA(b, h) (((b) * 2 + (h)) * HTB)
#define PG8_SB(b, h) ((4 + (b) * 2 + (h)) * HTB)
#define PG8_STAGE(bufoff, gbase, voff) do { _Pragma("unroll") for (int _i = 0; _i < 2; ++_i) \
        __builtin_amdgcn_global_load_lds((const unsigned*)((const char*)(gbase) + (voff)[_i]), (PG8_LAS unsigned*)(lds + (bufoff) + ldsw + _i * 8192), 16, 0, 0); } while (0)
#define PG8_LDA(dst, b, h) do { _Pragma("unroll") for (int m = 0; m < 4; ++m) _Pragma("unroll") for (int k = 0; k < 2; ++k) dst[m][k] = *(const PG8_LAS bf16x8*)(lds + PG8_SA(b, h) + aoff + m * 2048 + k * 1024); } while (0)
#define PG8_LDB(dst, b, h) do { _Pragma("unroll") for (int n = 0; n < 2; ++n) _Pragma("unroll") for (int k = 0; k < 2; ++k) dst[n][k] = *(const PG8_LAS bf16x8*)(lds + PG8_SB(b, h) + boff + n * 2048 + k * 1024); } while (0)
#define PG8_MMA(ai, bj, At, Bt) do { __builtin_amdgcn_s_setprio(1); _Pragma("unroll") for (int m = 0; m < 4; ++m) _Pragma("unroll") for (int n = 0; n < 2; ++n) _Pragma("unroll") for (int k = 0; k < 2; ++k) \
        acc[ai][bj][m][n] = __builtin_amdgcn_mfma_f32_16x16x32_bf16(Bt[n][k], At[m][k], acc[ai][bj][m][n], 0, 0, 0); __builtin_amdgcn_s_setprio(0); } while (0)
#define PG8_WAIT_V(n) asm volatile("s_waitcnt vmcnt(" #n ")" ::: "memory")
#define PG8_WAIT_L(n) asm volatile("s_waitcnt lgkmcnt(" #n ")" ::: "memory")
#define PG8_BAR __builtin_amdgcn_s_barrier()
#define PG8_SCHED __builtin_amdgcn_sched_barrier(0)
    Unit cur, nxt; int ui = 0;
    if (!S.next(0, cur)) return;
    f32x4 acc[2][2][4][2];
#pragma unroll
    for (int a = 0; a < 2; ++a)
#pragma unroll
        for (int b = 0; b < 2; ++b)
#pragma unroll
            for (int m = 0; m < 4; ++m)
#pragma unroll
                for (int n = 0; n < 2; ++n) acc[a][b][m][n] = (f32x4){0.f, 0.f, 0.f, 0.f};
    bf16x8 At[4][2], B0[2][2], B1[2][2];
    const char* cA = (const char*)g.A + (size_t)cur.pm * tstep; const char* cB = (const char*)g.Bt + (size_t)cur.pn * tstep;
    S.a_ready(cur);
    if constexpr (SP2) {
        PG8_STAGE(PG8_SB(0, 0), cB, voffB); PG8_STAGE(PG8_SB(0, 1), cB + hstep, voffB); PG8_STAGE(PG8_SA(0, 0), cA, voffA); PG8_STAGE(PG8_SA(0, 1), cA + hstep, voffA);
        if (wr == 1) PG8_BAR;
        PG8_WAIT_V(2); PG8_BAR;
        PG8_STAGE(PG8_SB(1, 0), cB + kstep, voffB); PG8_STAGE(PG8_SA(1, 0), cA + kstep, voffA); PG8_STAGE(PG8_SB(1, 1), cB + hstep + kstep, voffB);
        PG8_WAIT_V(6); PG8_BAR;
    } else {
        PG8_STAGE(PG8_SB(0, 0), cB, voffB); PG8_STAGE(PG8_SA(0, 0), cA, voffA); PG8_STAGE(PG8_SB(0, 1), cB + hstep, voffB); PG8_STAGE(PG8_SA(0, 1), cA + hstep, voffA);
        if (wr == 1) PG8_BAR;
        PG8_WAIT_V(4); PG8_BAR;
        PG8_STAGE(PG8_SB(1, 0), cB + kstep, voffB); PG8_STAGE(PG8_SA(1, 0), cA + kstep, voffA); PG8_STAGE(PG8_SB(1, 1), cB + hstep + kstep, voffB);
        PG8_WAIT_V(6); PG8_BAR;
    }
    for (;;) {
        const bool has_next = S.next(ui + 1, nxt);
        const char* nA = has_next ? (const char*)g.A + (size_t)nxt.pm * tstep : cA; const char* nB = has_next ? (const char*)g.Bt + (size_t)nxt.pn * tstep : cB;
        for (int t = 0; t < nt; t += 2) {
            const bool last = (t == nt - 2);
            const char* a1 = cA + (size_t)(t + 1) * kstep;
            const char* a2 = last ? nA : cA + (size_t)(t + 2) * kstep; const char* b2 = last ? nB : cB + (size_t)(t + 2) * kstep;
            const char* a3 = a2 + kstep; const char* b3 = b2 + kstep;
            if (last && has_next) S.a_ready(nxt);
            if constexpr (SP2) {
            PG8_LDB(B0, 0, 0); PG8_LDB(B1, 0, 1); PG8_SCHED; PG8_LDA(At, 0, 0); PG8_STAGE(PG8_SA(1, 1), a1 + hstep, voffA);
            PG8_WAIT_V(8); PG8_WAIT_L(0); PG8_BAR; PG8_MMA(0, 0, At, B0); PG8_MMA(0, 1, At, B1); PG8_BAR; PG8_SCHED;
            PG8_LDA(At, 0, 1); PG8_STAGE(PG8_SB(0, 0), b2, voffB); PG8_STAGE(PG8_SB(0, 1), b2 + hstep, voffB); PG8_STAGE(PG8_SA(0, 0), a2, voffA);
            PG8_WAIT_V(8); PG8_WAIT_L(0); PG8_BAR; PG8_MMA(1, 0, At, B0); PG8_MMA(1, 1, At, B1); PG8_BAR; PG8_SCHED;
            PG8_LDB(B0, 1, 0); PG8_LDB(B1, 1, 1); PG8_SCHED; PG8_LDA(At, 1, 0); PG8_STAGE(PG8_SA(0, 1), a2 + hstep, voffA);
            PG8_WAIT_V(8); PG8_WAIT_L(0); PG8_BAR; PG8_MMA(0, 0, At, B0); PG8_MMA(0, 1, At, B1); PG8_BAR; PG8_SCHED;
            PG8_LDA(At, 1, 1); PG8_STAGE(PG8_SB(1, 0), b3, voffB); PG8_STAGE(PG8_SB(1, 1), b3 + hstep, voffB); PG8_STAGE(PG8_SA(1, 0), a3, voffA);
            PG8_WAIT_V(8); PG8_WAIT_L(0); PG8_BAR; PG8_MMA(1, 0, At, B0); PG8_MMA(1, 1, At, B1); PG8_BAR; PG8_SCHED;
            } else {
            PG8_LDB(B0, 0, 0); PG8_SCHED; PG8_LDA(At, 0, 0); PG8_STAGE(PG8_SA(1, 1), a1 + hstep, voffA);
            PG8_WAIT_L(8); PG8_BAR; PG8_WAIT_L(0); PG8_MMA(0, 0, At, B0); PG8_BAR; PG8_SCHED;
            PG8_LDB(B1, 0, 1); PG8_STAGE(PG8_SB(0, 0), b2, voffB);
            PG8_BAR; PG8_WAIT_L(0); PG8_MMA(0, 1, At, B1); PG8_BAR;
            PG8_LDA(At, 0, 1); PG8_STAGE(PG8_SA(0, 0), a2, voffA);
            PG8_BAR; PG8_WAIT_L(0); PG8_MMA(1, 0, At, B0); PG8_BAR; PG8_SCHED;
            PG8_STAGE(PG8_SB(0, 1), b2 + hstep, voffB);
            PG8_WAIT_V(6); PG8_BAR; PG8_MMA(1, 1, At, B1); PG8_BAR;
            PG8_LDB(B0, 1, 0); PG8_SCHED; PG8_LDA(At, 1, 0); PG8_STAGE(PG8_SA(0, 1), a2 + hstep, voffA);
            PG8_WAIT_L(8); PG8_BAR; PG8_WAIT_L(0); PG8_MMA(0, 0, At, B0); PG8_BAR; PG8_SCHED;
            PG8_LDB(B1, 1, 1); PG8_STAGE(PG8_SB(1, 0), b3, voffB);
            PG8_BAR; PG8_WAIT_L(0); PG8_MMA(0, 1, At, B1); PG8_BAR;
            PG8_LDA(At, 1, 1); PG8_STAGE(PG8_SA(1, 0), a3, voffA);
            PG8_BAR; PG8_WAIT_L(0); PG8_MMA(1, 0, At, B0); PG8_BAR; PG8_SCHED;
            PG8_STAGE(PG8_SB(1, 1), b3 + hstep, voffB);
            PG8_WAIT_V(6); PG8_BAR; PG8_MMA(1, 1, At, B1); PG8_BAR;
            }
        }
        if constexpr (ALIGN_EPI) { if (wr == 0) PG8_BAR; }
        if constexpr (!Epi::AFTER_DRAIN) { E(acc, cur, wr, wc, fr, fq); S.done(cur); }
        if (!has_next) break;
#pragma unroll
        for (int a = 0; a < 2; ++a)
#pragma unroll
            for (int b = 0; b < 2; ++b)
#pragma unroll
                for (int m = 0; m < 4; ++m)
#pragma unroll
                    for (int n = 0; n < 2; ++n) acc[a][b][m][n] = (f32x4){0.f, 0.f, 0.f, 0.f};
        cur = nxt; cA = nA; cB = nB; ++ui;
        if constexpr (ALIGN_EPI) { if (wr == 1) PG8_BAR; }
    }
    PG8_WAIT_V(0);
    if constexpr (!ALIGN_EPI) { if (wr == 0) PG8_BAR; }
    PG8_BAR;
    if constexpr (Epi::AFTER_DRAIN) { E.fused(acc, cur, wr, wc, fr, fq, lds, wid, lane); S.done(cur); }
#undef PG8_SA
#undef PG8_SB
#undef PG8_STAGE
#undef PG8_LDA
#undef PG8_LDB
#undef PG8_MMA
#undef PG8_WAIT_V
#undef PG8_WAIT_L
#undef PG8_BAR
#undef PG8_SCHED
}
}

#ifndef PG8_SP2
#define PG8_SP2 true
#endif
#ifndef PG8_ALIGN
#define PG8_ALIGN true
#endif
#if defined(__HIP_DEVICE_COMPILE__)
#define GAS __attribute__((address_space(1)))
#else
#define GAS
#endif
#define LAS __attribute__((address_space(3)))
typedef unsigned short bf16;
typedef unsigned v4u __attribute__((ext_vector_type(4)));
typedef float f32x4 __attribute__((ext_vector_type(4)));
typedef short bf16x8 __attribute__((ext_vector_type(8)));
typedef GAS unsigned gu32;
typedef GAS unsigned long long gu64;
#define RLX_AGENT __ATOMIC_RELAXED, __HIP_MEMORY_SCOPE_AGENT
#define LDS_WAIT() asm volatile("s_waitcnt lgkmcnt(0)" ::: "memory")
#define VM_WAIT() asm volatile("s_waitcnt vmcnt(0)" ::: "memory")
__device__ __forceinline__ unsigned long long rt() { return __builtin_amdgcn_s_memrealtime(); }
__device__ __forceinline__ unsigned f2bf(float f) { unsigned u = __builtin_bit_cast(unsigned, f); return (u + 0x7fffu + ((u >> 16) & 1u)) >> 16; }
__device__ __forceinline__ unsigned pk2(float lo, float hi) { return f2bf(lo) | (f2bf(hi) << 16); }

#define XB_TMO      128
#define XB_XCNT(j)  (256  + 64 * (j))
#define XB_XSUB(j)  (1280 + 64 * (j))
#define XB_XGEN(j)  (2304 + 64 * (j))
#define XB_TOP      3328
#define XB_TOPGEN   3392
#define XCD_BAR_WORDS 3456
#define XB_SPIN_CAP (1u << 18)

__device__ __forceinline__ unsigned xb_ld(unsigned* p)              { return __hip_atomic_load(p, __ATOMIC_RELAXED, __HIP_MEMORY_SCOPE_AGENT); }
__device__ __forceinline__ unsigned xb_add(unsigned* p, unsigned v) { return __hip_atomic_fetch_add(p, v, __ATOMIC_RELAXED, __HIP_MEMORY_SCOPE_AGENT); }
__device__ __forceinline__ unsigned xb_xcc_id() { return (unsigned)__builtin_amdgcn_s_getreg((3 << 11) | 20) & 0xFu; }
#define XB_SPIN(cond, bar) do { unsigned _sp = 0; while (cond) { __builtin_amdgcn_s_sleep(1); \
    if ((++_sp & 255u) == 0u) { if (xb_ld(&(bar)[XB_TMO])) break; if (_sp > XB_SPIN_CAP) { atomicAdd(&(bar)[XB_TMO], 1u); break; } } } } while (0)

struct XcdBarrier {
    unsigned* bar; unsigned x;
    volatile LAS unsigned* st;
};

__device__ __forceinline__ XcdBarrier xcd_barrier_post(unsigned* bar, volatile LAS unsigned* st) {
    XcdBarrier b; b.bar = bar; b.x = xb_xcc_id(); b.st = st;
    if (threadIdx.x == 0) (void)xb_add(&bar[XB_XCNT(b.x)], 1u);
    return b;
}
__device__ __forceinline__ void xcd_barrier_complete(unsigned* bar, unsigned x, unsigned& nloc, unsigned& nx) {
    const unsigned G = gridDim.x * gridDim.y * gridDim.z;
    unsigned sum, cnt, mine, sp = 0u;
    for (;;) {
        sum = 0u; cnt = 0u; mine = 0u;
#pragma unroll
        for (unsigned j = 0; j < 16; ++j) { const unsigned c = xb_ld(&bar[XB_XCNT(j)]); sum += c; cnt += (c > 0u) ? 1u : 0u; mine = (j == x) ? c : mine; }
        if (sum == G) break;
        __builtin_amdgcn_s_sleep(1);
        if ((++sp & 255u) == 0u) { if (xb_ld(&bar[XB_TMO])) break; if (sp > XB_SPIN_CAP) { atomicAdd(&bar[XB_TMO], 1u); break; } }
    }
    nloc = mine > 0u ? mine : 1u; nx = cnt > 0u ? cnt : 1u;
}

__device__ __forceinline__ void xcd_barrier(const XcdBarrier& b) {
    asm volatile("s_waitcnt vmcnt(0)" ::: "memory");
    __syncthreads();
    if (threadIdx.x == 0) {
        unsigned* bar = b.bar;
        __builtin_amdgcn_s_waitcnt(0);
        unsigned nloc = b.st[0], nx = b.st[1];
        if (nloc == 0u) { xcd_barrier_complete(bar, b.x, nloc, nx); b.st[0] = nloc; b.st[1] = nx; }
        const unsigned old = xb_add(&bar[XB_XSUB(b.x)], 1u);
        const unsigned gen = old / nloc;
        if (old + 1u == (gen + 1u) * nloc) {
            __builtin_amdgcn_fence(__ATOMIC_RELEASE, "agent");
            asm volatile("s_waitcnt vmcnt(0)" ::: "memory");
            const unsigned og = xb_add(&bar[XB_TOP], 1u);
            const unsigned tg = og / nx;
            if (og + 1u == (tg + 1u) * nx) xb_add(&bar[XB_TOPGEN], 1u);
            else XB_SPIN(xb_ld(&bar[XB_TOPGEN]) == tg, bar);
            __builtin_amdgcn_fence(__ATOMIC_ACQUIRE, "agent");
            xb_add(&bar[XB_XGEN(b.x)], 1u);
            asm volatile("s_waitcnt vmcnt(0)" ::: "memory");
        } else {
            XB_SPIN(xb_ld(&bar[XB_XGEN(b.x)]) == gen, bar);
            __builtin_amdgcn_fence(__ATOMIC_ACQUIRE, "agent");
            asm volatile("s_waitcnt vmcnt(0)" ::: "memory");
        }
    }
    __syncthreads();
}
#ifndef MK_SINGLE
#define MK_SINGLE 1
#endif
constexpr int NWAVES = 8;
constexpr int DM = 1024, MT = 12288, MC = 8192, DEPTH = 4, PIN = 3688, PINP = 3840, FFD = 4096;
constexpr int TC = 256, TL = 1024;
constexpr int C_RW_WD = 768, C_RW_AD = 800, C_RW_GD = 832, RWC = 864;
constexpr int C_HG_Q = 864, C_HG_I = 1120, C_HG_F = 1376, C_HG_G = 1888;
constexpr int C_SS_Z = 2144, C_SS_XBC = 2400, C_SS_DT = 3168;
constexpr int C_LR_Y = 3176, C_LR_X = 3432;
enum { I_XP = 0, I_XS, I_SRW, I_SHG, I_SSS, I_SLR, I_C, I_CCTX, I_MODW, I_MODB, I_NORMG, I_WIN, I_WOUT, I_RWMU, I_RWW0, I_RWW2, I_RWA0, I_RWA2, I_RWG2, I_RWKK, I_RWKA, I_RWRK,
       I_RWLNW, I_RWLNB, I_HGLB, I_HGNORM, I_SSCW, I_SSCB, I_SSDTB, I_SSALOG, I_SSD, I_SSNORM, I_LRCW, I_LRCB, I_LRWA, I_LRBA, I_LRWX, I_LRBX, I_LRLAM, I_W1, I_W2, N_IN };
constexpr size_t O_X = 0, O_SRW = 12582912, O_SHG = 16777216, O_SSS = 20971520, O_SLR = 29360128, O_END = 29425664;
constexpr size_t MiB = 1u << 20;
constexpr size_t WS_CTL = 0, CTL_ZERO_BYTES = 1 * MiB;
constexpr size_t WS_MOD = 1 * MiB;
constexpr size_t WS_LB = 1 * MiB + 512 * 1024;
constexpr size_t WS_WLR = 2 * MiB;
constexpr size_t WS_WIN = 3 * MiB;
constexpr size_t WS_WOUT = 33 * MiB;
constexpr size_t WS_W1 = 41 * MiB;
constexpr size_t WS_W2 = 73 * MiB;
constexpr size_t WS_PROJ = 105 * MiB;
constexpr size_t WS_U = WS_PROJ;
constexpr size_t A6 = 6 * MiB;
constexpr int NBLK = MT / 16;
constexpr size_t WS_RW_R = 195 * MiB, WS_RW_V = WS_RW_R + A6, WS_RW_G = WS_RW_V + A6, WS_RW_E = WS_RW_G + A6  , WS_RW_KK = WS_RW_E + 2 * A6, WS_RW_KD = WS_RW_KK + A6  ,
                 WS_RW_B = WS_RW_KD + 2 * A6  , WS_RW_BON = WS_RW_B + 2 * A6  ;
constexpr size_t WS_MIX = WS_RW_KK;
constexpr size_t WS_HG_QT = WS_RW_BON + 1 * MiB  , WS_HG_KD = WS_HG_QT + 2 * A6  , WS_HG_KT = WS_HG_KD + 2 * A6  , WS_HG_VT = WS_HG_KT + 2 * A6  ,
                 WS_HG_G = WS_HG_VT + A6  ;
constexpr size_t WS_SS_B = WS_HG_G + 2 * MiB, WS_SS_C = WS_SS_B + A6, WS_SS_BT = WS_SS_C + A6, WS_SS_XT = WS_SS_BT + A6  , WS_SS_XWT = WS_SS_XT + 2 * A6  ,
                 WS_SS_CIN = WS_SS_XWT + 2 * A6  , WS_SS_G = WS_SS_CIN + 512 * 1024  , WS_SS_DT = WS_SS_CIN + 768 * 1024  ;
constexpr size_t WS_LR_AL = WS_SS_CIN + 1 * MiB  , WS_LR_HL = WS_LR_AL + 2 * A6  , WS_LR_AE = WS_LR_HL + 2 * A6  , WS_LR_HE = WS_LR_AE + 2 * MiB, WS_LR_HIN = WS_LR_HE + 2 * MiB;
constexpr size_t WS_YS = WS_LR_HIN + 2 * MiB;
constexpr size_t WS_END = WS_YS + 4 * A6;
constexpr size_t WS_H = WS_HG_QT;
constexpr size_t WS_GO = WS_SS_B;
static_assert(WS_RW_BON == 255 * MiB && WS_HG_QT == 256 * MiB && WS_SS_B == 300 * MiB && WS_LR_AL == 343 * MiB && WS_YS == 373 * MiB && WS_END == 397 * MiB, "ws map");
static_assert(WS_U + 96 * MiB <= WS_RW_V && WS_MIX + 24 * MiB <= WS_RW_BON && WS_H + 24 * MiB <= WS_HG_KT && WS_GO + 48 * MiB <= WS_LR_AL + 6 * MiB, "overlays");
constexpr int CW_BAR = 4096;
constexpr int RING_BYTES = 131072, LDSCTL_OFF = RING_BYTES, MISC_OFF = LDSCTL_OFF + 320, LDS_BYTES = 147456;

#ifndef REPMASK
#define REPMASK 0
#endif
#define NREP(x) (((REPMASK >> (x)) & 1) ? 2 : 1)
typedef float f4 __attribute__((ext_vector_type(4)));
typedef float f2 __attribute__((ext_vector_type(2)));
__device__ __forceinline__ float bf2f(bf16 v) { return __uint_as_float((unsigned)v << 16); }
__device__ __forceinline__ float bflo(unsigned w) { return __uint_as_float(w << 16); }
__device__ __forceinline__ float bfhi(unsigned w) { return __uint_as_float(w & 0xffff0000u); }
__device__ __forceinline__ float sigmoidf_(float x) { return 1.f / (1.f + __expf(-x)); }
__device__ __forceinline__ float siluf_(float x) { return x / (1.f + __expf(-x)); }
__device__ __forceinline__ float softplusf_(float x) { return x > 20.f ? x : log1pf(__expf(x)); }
__device__ __forceinline__ float gelu_tanh(float x) { const float u = 0.7978845608028654f * (x + 0.044715f * x * x * x); return 0.5f * x * (1.f + tanhf(u)); }
__device__ __forceinline__ float wave_sum(float v) {
#pragma unroll
    for (int o = 1; o < 64; o <<= 1) v += __shfl_xor(v, o);
    return v;
}
template <int CTRL> __device__ __forceinline__ float dppf(float v) {
    return __builtin_bit_cast(float, __builtin_amdgcn_update_dpp(0, __builtin_bit_cast(int, v), CTRL, 0xF, 0xF, true));
}
__device__ __forceinline__ float sum16(float v) {
    v += dppf<0xB1>(v); v += dppf<0x4E>(v); v += dppf<0x141>(v); v += dppf<0x140>(v); return v;
}
__device__ __forceinline__ void cvt8(const v4u w, float (&o)[8]) {
    o[0] = bflo(w.x); o[1] = bfhi(w.x); o[2] = bflo(w.y); o[3] = bfhi(w.y); o[4] = bflo(w.z); o[5] = bfhi(w.z); o[6] = bflo(w.w); o[7] = bfhi(w.w);
}
__device__ __forceinline__ void st8(LAS float* p, const float (&o)[8]) { *(LAS f4*)p = (f4){o[0], o[1], o[2], o[3]}; *(LAS f4*)(p + 4) = (f4){o[4], o[5], o[6], o[7]}; }

struct Ctx {
    float* out; unsigned char* ws;
    int tid, lane, wave, G, wg;
    LAS unsigned char* lds;
};
constexpr int PTAB_OFF = 131584;
typedef const GAS float* gcf;
__device__ __forceinline__ gcf ldptr(const Ctx& C, int i) {
    const LAS unsigned* t = (const LAS unsigned*)(C.lds + PTAB_OFF) + 2 * i;
    const unsigned lo = __builtin_amdgcn_readfirstlane(t[0]), hi = __builtin_amdgcn_readfirstlane(t[1]);
    return (gcf)(((unsigned long long)hi << 32) | (unsigned long long)lo);
}
#define INP(i) ldptr(C, (i))
#define WSP(T, off) ((GAS T*)(C.ws + (off)))

__device__ __forceinline__ void tr_item(const float* W, int K, int N, int Np, bf16* WT, LAS float* scr, int item, int lane) {
    const int nblk = Np / 32, kb = item / nblk, nb = item % nblk, k0 = 64 * kb, n0 = 32 * nb;
    const int nn = n0 + (lane & 31); const bool ok = nn < N;
#pragma unroll 8
    for (int i = 0; i < 32; ++i) { const int kk = 2 * i + (lane >> 5); scr[kk * 33 + (lane & 31)] = ok ? W[(size_t)(k0 + kk) * N + nn] : 0.f; }
    LDS_WAIT(); asm volatile("" ::: "memory");
    const int c = lane & 7;
#pragma unroll
    for (int j = 0; j < 4; ++j) { const int n = (lane >> 3) + 8 * j; const LAS float* s = scr + (8 * c) * 33 + n;
        v4u o; o.x = pk2(s[0 * 33], s[1 * 33]); o.y = pk2(s[2 * 33], s[3 * 33]); o.z = pk2(s[4 * 33], s[5 * 33]); o.w = pk2(s[6 * 33], s[7 * 33]);
        *(GAS v4u*)(WT + (size_t)(n0 + n) * K + k0 + 8 * c) = o; }
    LDS_WAIT(); asm volatile("" ::: "memory");
}
__device__ __forceinline__ void p0_prologue(const Ctx& C) {
    const int gw = C.wg * NWAVES + C.wave, NGW = C.G * NWAVES;
    {
        LAS float* scr = (LAS float*)(C.lds + C.wave * 16384);
        constexpr int I_IN = 16 * (PINP / 32), I_OUT = 16 * 32, I_1 = 16 * (FFD / 32), I_2 = 64 * 32, I_L = I_IN + I_OUT + I_1 + I_2;
        for (int it = gw; it < DEPTH * I_L; it += NGW) {
            const int l = it / I_L; int r = it - l * I_L;
            if (r < I_IN) { tr_item(INP(I_WIN) + (size_t)l * DM * PIN, DM, PIN, PINP, WSP(bf16, WS_WIN) + (size_t)l * PINP * DM, scr, r, C.lane); continue; } r -= I_IN;
            if (r < I_OUT) { tr_item(INP(I_WOUT) + (size_t)l * DM * DM, DM, DM, DM, WSP(bf16, WS_WOUT) + (size_t)l * DM * DM, scr, r, C.lane); continue; } r -= I_OUT;
            if (r < I_1) { tr_item(INP(I_W1) + (size_t)l * DM * FFD, DM, FFD, FFD, WSP(bf16, WS_W1) + (size_t)l * FFD * DM, scr, r, C.lane); continue; } r -= I_1;
            tr_item(INP(I_W2) + (size_t)l * FFD * DM, FFD, DM, DM, WSP(bf16, WS_W2) + (size_t)l * DM * FFD, scr, r, C.lane);
        }
    }
    {
        bf16* WLR = WSP(bf16, WS_WLR);
        for (int o = C.wg * 512 + C.tid; o < DEPTH * 2 * 2 * 4 * 64 * 64; o += C.G * 512) {
            const int i = o & 63, j = (o >> 6) & 63, h = (o >> 12) & 3, g = (o >> 14) & 1, d = (o >> 15) & 1, l = o >> 16;
            const float* src = g ? INP(I_LRWX) : INP(I_LRWA);
            WLR[o] = (bf16)f2bf(src[((((size_t)l * 2 + d) * 4 + h) * 64 + i) * 64 + j]);
        }
    }
    {
        float* LB = WSP(float, WS_LB);
        for (int o = C.wg * 512 + C.tid; o < 512; o += C.G * 512) {
            float v[4], mx = -1e30f;
#pragma unroll
            for (int l = 0; l < 4; ++l) { v[l] = INP(I_HGLB)[l * 512 + o]; mx = fmaxf(mx, v[l]); }
            float s = 0.f;
#pragma unroll
            for (int l = 0; l < 4; ++l) { v[l] = expf(v[l] - mx); s += v[l]; }
            const float inv = 1.f / s; float cum = 0.f;
#pragma unroll
            for (int l = 0; l < 4; ++l) { const float p = v[l] * inv; cum += p; LB[l * 512 + o] = cum - v[0] * inv; }
        }
    }
    __syncthreads();
    {
        LAS float* SC = (LAS float*)C.lds;
        LAS float* RED = SC + 5 * 1024;
        bool staged = false;
        for (int u = C.wg; u < DEPTH * 48; u += C.G) {
            if (!staged) {
                for (int e = C.tid; e < 5 * 1024; e += 512) { const int cnd = e >> 10, k = e & 1023; const float x = cnd == 0 ? INP(I_CCTX)[k] : INP(I_C)[(cnd - 1) * 1024 + k]; SC[e] = siluf_(x); }
                staged = true;
            }
            __syncthreads();
            const int l = u / 48, j0 = (u % 48) * 128 + 2 * C.lane;
            const float* wp = INP(I_MODW) + (size_t)l * DM * 6144 + j0;
            float acc[5][2];
#pragma unroll
            for (int cnd = 0; cnd < 5; ++cnd) { acc[cnd][0] = 0.f; acc[cnd][1] = 0.f; }
            const int kb = C.wave * 128;
#pragma unroll 8
            for (int k = kb; k < kb + 128; ++k) { const f2 w = *(const f2*)(wp + (size_t)k * 6144);
#pragma unroll
                for (int cnd = 0; cnd < 5; ++cnd) { const float s = SC[cnd * 1024 + k]; acc[cnd][0] += s * w.x; acc[cnd][1] += s * w.y; } }
#pragma unroll
            for (int cnd = 0; cnd < 5; ++cnd) { RED[(C.wave * 5 + cnd) * 128 + 2 * C.lane] = acc[cnd][0]; RED[(C.wave * 5 + cnd) * 128 + 2 * C.lane + 1] = acc[cnd][1]; }
            __syncthreads();
            for (int e = C.tid; e < 5 * 128; e += 512) { const int cnd = e >> 7, j = e & 127; float s = 0.f;
#pragma unroll
                for (int w = 0; w < 8; ++w) s += RED[(w * 5 + cnd) * 128 + j];
                const int col = (u % 48) * 128 + j;
                WSP(float, WS_MOD)[((size_t)l * 5 + cnd) * 6144 + col] = s + INP(I_MODB)[l * 6144 + col]; }
        }
        __syncthreads();
    }
}

__device__ __forceinline__ const float* mod_row(const Ctx& C, int l, int m) { const int cnd = m < MC ? 0 : 1 + ((m - MC) >> 10); return WSP(const float, WS_MOD) + ((size_t)l * 5 + cnd) * 6144; }
__device__ __forceinline__ void write_h(const Ctx& C, const f4 (&x)[4], float ssq, const float* g, const float* sc, const float* sh, bf16* hrow) {
    const float rs = rsqrtf(ssq * (1.f / DM) + 1e-6f);
#pragma unroll
    for (int j = 0; j < 4; ++j) { const int c = 4 * C.lane + 256 * j; const f4 gg = *(const f4*)(g + c), s1 = *(const f4*)(sc + c), s0 = *(const f4*)(sh + c);
        const f4 y = x[j] * rs * gg * (1.f + s1) + s0;
        *(GAS unsigned long long*)(hrow + c) = (unsigned long long)pk2(y.x, y.y) | ((unsigned long long)pk2(y.z, y.w) << 32); }
}
__device__ __forceinline__ void phase_norm_in(const Ctx& C) {
    const int gw = C.wg * NWAVES + C.wave, NGW = C.G * NWAVES;
    const float* ng = INP(I_NORMG);
    for (int m = gw; m < MT; m += NGW) {
        const float* xr = m < MC ? INP(I_XP) + (size_t)m * DM : INP(I_XS) + (size_t)(m - MC) * DM;
        float* xo = C.out + O_X + (size_t)m * DM;
        f4 x[4]; float ss = 0.f;
#pragma unroll
        for (int j = 0; j < 4; ++j) { x[j] = *(const f4*)(xr + 4 * C.lane + 256 * j); *(f4*)(xo + 4 * C.lane + 256 * j) = x[j]; ss += (x[j].x * x[j].x + x[j].y * x[j].y) + (x[j].z * x[j].z + x[j].w * x[j].w); }
        ss = wave_sum(ss);
        const float* md = mod_row(C, 0, m);
        write_h(C, x, ss, ng + 0 * DM, md + 1 * DM, md + 0 * DM, WSP(bf16, WS_H) + (size_t)m * DM);
    }
}
__device__ __forceinline__ void phase_norm_res(const Ctx& C, int l, int which) {
    const int gw = C.wg * NWAVES + C.wave, NGW = C.G * NWAVES;
    const float* ng = INP(I_NORMG);
    const float* gpost = ng + ((size_t)l * 4 + (which ? 3 : 1)) * DM;
    const bool wh = which == 0 || l + 1 < DEPTH;
    const int ln = which ? l + 1 : l;
    const float* gpre = ng + ((size_t)ln * 4 + (which ? 0 : 2)) * DM;
    const float* GO = WSP(const float, WS_GO);
    for (int m = gw; m < MT; m += NGW) {
        const float* gr = GO + (size_t)m * DM; float* xo = C.out + O_X + (size_t)m * DM;
        const float* md = mod_row(C, l, m);
        const float* gate = md + (which ? 5 : 2) * DM;
        f4 go[4], x[4]; float ss = 0.f;
#pragma unroll
        for (int j = 0; j < 4; ++j) { go[j] = *(const f4*)(gr + 4 * C.lane + 256 * j); x[j] = *(const f4*)(xo + 4 * C.lane + 256 * j); ss += (go[j].x * go[j].x + go[j].y * go[j].y) + (go[j].z * go[j].z + go[j].w * go[j].w); }
        ss = wave_sum(ss);
        const float rs = rsqrtf(ss * (1.f / DM) + 1e-6f); float s2 = 0.f;
#pragma unroll
        for (int j = 0; j < 4; ++j) { const int c = 4 * C.lane + 256 * j; const f4 gp = *(const f4*)(gpost + c), gt = *(const f4*)(gate + c);
            x[j] = x[j] + gt * (go[j] * rs * gp); *(f4*)(xo + c) = x[j]; s2 += (x[j].x * x[j].x + x[j].y * x[j].y) + (x[j].z * x[j].z + x[j].w * x[j].w); }
        if (wh) {
            s2 = wave_sum(s2);
            const float* md2 = mod_row(C, ln, m);
            write_h(C, x, s2, gpre, md2 + (which ? 1 : 4) * DM, md2 + (which ? 0 : 3) * DM, WSP(bf16, WS_H) + (size_t)m * DM);
        }
    }
}

typedef unsigned v2u __attribute__((ext_vector_type(2)));
#define WAVE_LDS_SYNC() do { asm volatile("s_waitcnt lgkmcnt(0)" ::: "memory"); } while (0)
__device__ __forceinline__ v2u ld8(const bf16* p) { return *(const GAS v2u*)p; }
__device__ __forceinline__ void st16bf(bf16* p, const float (&v)[16]) {
    v4u a, b; a.x = pk2(v[0], v[1]); a.y = pk2(v[2], v[3]); a.z = pk2(v[4], v[5]); a.w = pk2(v[6], v[7]); b.x = pk2(v[8], v[9]); b.y = pk2(v[10], v[11]); b.z = pk2(v[12], v[13]); b.w = pk2(v[14], v[15]);
    *(GAS v4u*)p = a; *(GAS v4u*)(p + 8) = b;
}
__device__ __forceinline__ float rw_mix(const bf16* PROJ, gcf mu, bool lat, int T, int m, int t, int col) {
    const float p = bf2f(PROJ[(size_t)m * PINP + col]);
    bool ok; int src;
    if (!lat) { const bool fw = col >= 432; ok = fw ? (t <= T - 2) : (t >= 1); src = fw ? m + 1 : m - 1; }
    else { const int gc = t & 63, gr = t >> 6; const int qd = col < 216 ? 0 : (col < 432 ? 1 : (col < 648 ? 2 : 3));
        ok = qd == 0 ? gc > 0 : (qd == 1 ? gc < 63 : (qd == 2 ? gr > 0 : gr < 15)); src = qd == 0 ? m - 1 : (qd == 1 ? m + 1 : (qd == 2 ? m - 64 : m + 64)); }
    src = ok ? src : m;
    const float s = ok ? bf2f(PROJ[(size_t)src * PINP + col]) : 0.f;
    return p + (s - p) * mu[col];
}
__device__ __forceinline__ void prep_rw(const Ctx& C, int l, int job) {
    const int lane = C.lane, h = job & 3, m0 = (job >> 2) * 8;
    const bool lat = m0 >= MC; const int T = lat ? TL : TC; const int ms = lat ? MC + (((m0 - MC) >> 10) << 10) : (m0 & ~255); const int t0 = m0 - ms;
    const bf16* PROJ = WSP(const bf16, WS_PROJ); gcf mu = INP(I_RWMU) + l * RWC;
    LAS float* MX = (LAS float*)(C.lds + C.wave * 16384);
    LAS float* RKV = MX + 768;
#pragma unroll
    for (int i = 0; i < 12; ++i) { const int idx = lane + 64 * i, j = idx / 96, e = idx - j * 96;
        float v = rw_mix(PROJ, mu, lat, T, m0 + j, t0 + j, 768 + e); v = e < 32 ? tanhf(v) : (e < 64 ? v : sigmoidf_(v)); MX[idx] = v; }
#pragma unroll
    for (int j = 0; j < 8; ++j)
#pragma unroll
        for (int part = 0; part < 3; ++part) RKV[(j * 3 + part) * 64 + lane] = rw_mix(PROJ, mu, lat, T, m0 + j, t0 + j, part * 256 + h * 64 + lane);
    WAVE_LDS_SYNC();
    int c = h * 64 + lane; asm volatile("" : "+v"(c));
    bf16* oR = WSP(bf16, WS_RW_R); bf16* oKK = WSP(bf16, WS_RW_KK); bf16* oV = WSP(bf16, WS_RW_V); bf16* oKD = WSP(bf16, WS_RW_KD); bf16* oB = WSP(bf16, WS_RW_B);
    bf16* oG = WSP(bf16, WS_RW_G); bf16* oE = WSP(bf16, WS_RW_E); float* oBON = WSP(float, WS_RW_BON);
    {
        float w2r[2][16], a2r[2][16];
#pragma unroll
        for (int d = 0; d < 2; ++d)
#pragma unroll
            for (int jj = 0; jj < 16; ++jj) { w2r[d][jj] = INP(I_RWW2)[(((size_t)l * 2 + d) * 16 + jj) * 256 + c]; a2r[d][jj] = INP(I_RWA2)[(((size_t)l * 2 + d) * 16 + jj) * 256 + c]; }
        const float w0_0 = INP(I_RWW0)[(l * 2 + 0) * 256 + c], w0_1 = INP(I_RWW0)[(l * 2 + 1) * 256 + c];
        const float a0_0 = INP(I_RWA0)[(l * 2 + 0) * 256 + c], a0_1 = INP(I_RWA0)[(l * 2 + 1) * 256 + c];
        const float kkw = INP(I_RWKK)[l * 256 + c], ka = INP(I_RWKA)[l * 256 + c], rk = INP(I_RWRK)[l * 256 + c];
#pragma unroll 1
        for (int j = 0; j < 8; ++j) {
            const size_t m = (size_t)(m0 + j);
            const float r = RKV[(j * 3 + 0) * 64 + lane], k = RKV[(j * 3 + 1) * 64 + lane], v = RKV[(j * 3 + 2) * 64 + lane];
            const float kkr = k * kkw; const float ssq = wave_sum(kkr * kkr); const float kkn = kkr / fmaxf(sqrtf(ssq), 1e-12f);
            float lw0 = 0.f, lw1 = 0.f, la0 = 0.f, la1 = 0.f;
#pragma unroll
            for (int jj = 0; jj < 16; ++jj) { lw0 += MX[j * 96 + jj] * w2r[0][jj]; lw1 += MX[j * 96 + 16 + jj] * w2r[1][jj]; la0 += MX[j * 96 + 32 + jj] * a2r[0][jj]; la1 += MX[j * 96 + 48 + jj] * a2r[1][jj]; }
            const float e0 = 0.6065306597126334f * sigmoidf_(w0_0 + lw0), e1 = 0.6065306597126334f * sigmoidf_(w0_1 + lw1);
            const float a0 = sigmoidf_(a0_0 + la0), a1 = sigmoidf_(a0_1 + la1);
            const float kd0 = k * (1.f + (a0 - 1.f) * ka), kd1 = k * (1.f + (a1 - 1.f) * ka);
            const float bon = wave_sum(r * (kd0 + kd1) * rk);
            if (lane == 0) oBON[m * 4 + h] = bon;
            const size_t o = m * 256 + c, o1 = ((size_t)MT + m) * 256 + c;
            oR[o] = (bf16)f2bf(r); oKK[o] = (bf16)f2bf(kkn); oV[o] = (bf16)f2bf(v);
            oKD[o] = (bf16)f2bf(kd0); oKD[o1] = (bf16)f2bf(kd1); oB[o] = (bf16)f2bf(kkn * a0); oB[o1] = (bf16)f2bf(kkn * a1);
            oE[o] = (bf16)f2bf(e0); oE[o1] = (bf16)f2bf(e1);
        }
    }
    {
        float g2r[32];
#pragma unroll
        for (int jj = 0; jj < 32; ++jj) g2r[jj] = INP(I_RWG2)[((size_t)l * 32 + jj) * 256 + c];
#pragma unroll 1
        for (int j = 0; j < 8; ++j) { float g = 0.f;
#pragma unroll
            for (int jj = 0; jj < 32; ++jj) g += MX[j * 96 + 64 + jj] * g2r[jj];
            oG[(size_t)(m0 + j) * 256 + c] = (bf16)f2bf(g); }
    }
    WAVE_LDS_SYNC();
}
__device__ __forceinline__ void prep_hg(const Ctx& C, int l, int job) {
    const int lane = C.lane, h = job & 3, d = (job >> 2) & 1, blk = job >> 3, m0 = blk * 16, c = h * 64 + lane;
    const bf16* PROJ = WSP(const bf16, WS_PROJ) + (size_t)m0 * PINP;
    float q[16], fr[16];
#pragma unroll
    for (int j = 0; j < 16; ++j) { q[j] = bf2f(PROJ[(size_t)j * PINP + C_HG_Q + c]); fr[j] = bf2f(PROJ[(size_t)j * PINP + C_HG_F + d * 256 + c]); }
    if (d == 0) { float iv[16];
#pragma unroll
        for (int j = 0; j < 16; ++j) iv[j] = bf2f(PROJ[(size_t)j * PINP + C_HG_I + c]);
        st16bf(WSP(bf16, WS_HG_VT) + ((size_t)blk * 256 + c) * 16, iv); }
    const float lb = WSP(const float, WS_LB)[(l * 2 + d) * 256 + c], omlb = 1.f - lb;
    float kd[16], lf[16], cin[16];
#pragma unroll
    for (int j = 0; j < 16; ++j) { const float sg = sigmoidf_(fr[j]); kd[j] = omlb * (1.f - sg); lf[j] = __logf(fmaxf(lb + omlb * sg, 1e-30f)); }
    float run = 0.f;
#pragma unroll
    for (int jj = 0; jj < 16; ++jj) { const int j = d ? 15 - jj : jj; run += lf[j]; cin[j] = run; }
    const float tot = run;
    bf16* oQT = WSP(bf16, WS_HG_QT) + ((size_t)d * MT + m0) * 256 + c; bf16* oKD = WSP(bf16, WS_HG_KD) + ((size_t)d * MT + m0) * 256 + c;
    float kt[16];
#pragma unroll
    for (int j = 0; j < 16; ++j) { oQT[(size_t)j * 256] = (bf16)f2bf(siluf_(q[j]) * __expf(cin[j])); oKD[(size_t)j * 256] = (bf16)f2bf(kd[j] * __expf(fminf(-cin[j], 60.f))); kt[j] = kd[j] * __expf(tot - cin[j]); }
    st16bf(WSP(bf16, WS_HG_KT) + (((size_t)d * NBLK + blk) * 256 + c) * 16, kt);
    WSP(float, WS_HG_G)[((size_t)d * NBLK + blk) * 256 + c] = __expf(tot);
}
__device__ __forceinline__ void conv16(const bf16* col, int t0, int T, const float (&w)[4], float bias, float (&y)[16]) {
    float x[19];
#pragma unroll
    for (int i = 0; i < 19; ++i) { const int t = t0 - 2 + i; const bool ok = t >= 0 && t < T; const float v = bf2f(col[(size_t)(ok ? t : t0) * PINP]); x[i] = ok ? v : 0.f; }
#pragma unroll
    for (int j = 0; j < 16; ++j) y[j] = bias + w[0] * x[j] + w[1] * x[j + 1] + w[2] * x[j + 2] + w[3] * x[j + 3];
}
__device__ __forceinline__ void prep_ss(const Ctx& C, int l, int job) {
    const int lane = C.lane, grp = job % 12, blk = job / 12, kind = grp >> 2, sub = grp & 3, m0 = blk * 16, cc = sub * 64 + lane, c = kind * 256 + cc;
    const bool lat = m0 >= MC; const int T = lat ? TL : TC; const int ms = lat ? MC + (((m0 - MC) >> 10) << 10) : (m0 & ~255); const int t0 = m0 - ms;
    const bf16* PROJ = WSP(const bf16, WS_PROJ);
    float w[4], y[16];
#pragma unroll
    for (int j = 0; j < 4; ++j) w[j] = INP(I_SSCW)[((size_t)l * 4 + j) * 768 + c];
    conv16(PROJ + (size_t)ms * PINP + C_SS_XBC + c, t0, T, w, INP(I_SSCB)[l * 768 + c], y);
#pragma unroll
    for (int j = 0; j < 16; ++j) y[j] = siluf_(y[j]);
    if (kind == 2) { bf16* o = WSP(bf16, WS_SS_C) + (size_t)m0 * 256 + cc;
#pragma unroll
        for (int j = 0; j < 16; ++j) o[(size_t)j * 256] = (bf16)f2bf(y[j]); }
    else if (kind == 1) { bf16* o = WSP(bf16, WS_SS_B) + (size_t)m0 * 256 + cc;
#pragma unroll
        for (int j = 0; j < 16; ++j) o[(size_t)j * 256] = (bf16)f2bf(y[j]);
        st16bf(WSP(bf16, WS_SS_BT) + ((size_t)blk * 256 + cc) * 16, y); }
    else {
        const int h = sub;
        LAS float* DTs = (LAS float*)(C.lds + C.wave * 16384);
        if (lane < 32) { const int dd = lane >> 4, j = lane & 15;
            const float dtr = bf2f(PROJ[(size_t)(m0 + j) * PINP + C_SS_DT + dd * 4 + h]);
            const float dt = softplusf_(dtr + INP(I_SSDTB)[(l * 2 + dd) * 4 + h]);
            DTs[lane] = dt; DTs[32 + lane] = dt * (-__expf(INP(I_SSALOG)[(l * 2 + dd) * 4 + h])); }
        WAVE_LDS_SYNC();
#pragma unroll
        for (int dd = 0; dd < 2; ++dd) {
            float dt[16], cin[16], run = 0.f;
#pragma unroll
            for (int j = 0; j < 16; ++j) dt[j] = DTs[dd * 16 + j];
#pragma unroll
            for (int jj = 0; jj < 16; ++jj) { const int j = dd ? 15 - jj : jj; run += DTs[32 + dd * 16 + j]; cin[j] = run; }
            const float tot = run;
            float xt[16], xw[16];
#pragma unroll
            for (int j = 0; j < 16; ++j) { xt[j] = y[j] * dt[j]; xw[j] = xt[j] * __expf(tot - cin[j]); }
            st16bf(WSP(bf16, WS_SS_XT) + (((size_t)dd * NBLK + blk) * 256 + cc) * 16, xt);
            st16bf(WSP(bf16, WS_SS_XWT) + (((size_t)dd * NBLK + blk) * 256 + cc) * 16, xw);
            if (lane == dd) {
                float* oc = WSP(float, WS_SS_CIN) + (((size_t)dd * NBLK + blk) * 4 + h) * 16;
#pragma unroll
                for (int j = 0; j < 16; ++j) oc[j] = cin[j];
                WSP(float, WS_SS_G)[((size_t)dd * NBLK + blk) * 4 + h] = __expf(tot);
                if (dd == 0) { float* od = WSP(float, WS_SS_DT) + ((size_t)blk * 4 + h) * 16;
#pragma unroll
                    for (int j = 0; j < 16; ++j) od[j] = dt[j]; }
            }
        }
        WAVE_LDS_SYNC();
    }
}
__device__ __forceinline__ void prep_lr(const Ctx& C, int l, int job) {
    const int lane = C.lane, h = job & 3, d = (job >> 2) & 1, blk = job >> 3, m0 = blk * 16, c = h * 64 + lane;
    const bool lat = m0 >= MC; const int T = lat ? TL : TC; const int ms = lat ? MC + (((m0 - MC) >> 10) << 10) : (m0 & ~255); const int t0 = m0 - ms;
    const bf16* PROJ = WSP(const bf16, WS_PROJ);
    LAS float* XCf = (LAS float*)(C.lds + C.wave * 16384);
    LAS float* LAQ = XCf + 1024;
    LAS float* BQ = XCf + 2048;
    LAS bf16* XCb = (LAS bf16*)(XCf + 3072);
    {
        float w[4], y[16];
#pragma unroll
        for (int j = 0; j < 4; ++j) w[j] = INP(I_LRCW)[((size_t)l * 4 + j) * 256 + c];
        conv16(PROJ + (size_t)ms * PINP + C_LR_X + c, t0, T, w, INP(I_LRCB)[l * 256 + c], y);
#pragma unroll
        for (int j = 0; j < 16; ++j) { XCf[j * 64 + lane] = y[j]; XCb[j * 72 + lane] = (bf16)f2bf(y[j]); }
    }
    WAVE_LDS_SYNC();
    {
        const int fr = lane & 15, fq = lane >> 4;
        f32x4 acc[2][4];
#pragma unroll
        for (int g = 0; g < 2; ++g)
#pragma unroll
            for (int nt = 0; nt < 4; ++nt) acc[g][nt] = (f32x4){0.f, 0.f, 0.f, 0.f};
        const bf16* WLR = WSP(const bf16, WS_WLR);
#pragma unroll
        for (int ks = 0; ks < 2; ++ks) {
            const bf16x8 A = *(const LAS bf16x8*)(XCb + fr * 72 + ks * 32 + 8 * fq);
#pragma unroll
            for (int g = 0; g < 2; ++g)
#pragma unroll
                for (int nt = 0; nt < 4; ++nt) {
                    const bf16x8 B = *(const GAS bf16x8*)(WLR + ((((size_t)(l * 2 + d) * 2 + g) * 4 + h) * 64 + nt * 16 + fr) * 64 + ks * 32 + 8 * fq);
                    acc[g][nt] = __builtin_amdgcn_mfma_f32_16x16x32_bf16(A, B, acc[g][nt], 0, 0, 0);
                }
        }
#pragma unroll
        for (int nt = 0; nt < 4; ++nt) {
            const int ch = nt * 16 + fr, cg = h * 64 + ch;
            const float ba = INP(I_LRBA)[(l * 2 + d) * 256 + cg], bx = INP(I_LRBX)[(l * 2 + d) * 256 + cg];
            const float sp = softplusf_(-INP(I_LRLAM)[(l * 2 + d) * 256 + cg]);
#pragma unroll
            for (int rg = 0; rg < 4; ++rg) {
                const int j = fq * 4 + rg;
                const float r = sigmoidf_(acc[0][nt][rg] + ba), ig = sigmoidf_(acc[1][nt][rg] + bx);
                const float la = -8.f * r * sp;
                LAQ[j * 64 + ch] = la; BQ[j * 64 + ch] = sqrtf(fmaxf(-expm1f(2.f * la), 0.f)) * (ig * XCf[j * 64 + ch]);
            }
        }
    }
    WAVE_LDS_SYNC();
    {
        float A = 1.f, H = 0.f;
        bf16* oAL = WSP(bf16, WS_LR_AL) + ((size_t)d * MT + m0) * 256 + c; bf16* oHL = WSP(bf16, WS_LR_HL) + ((size_t)d * MT + m0) * 256 + c;
#pragma unroll
        for (int jj = 0; jj < 16; ++jj) { const int j = d ? 15 - jj : jj; const float a = __expf(LAQ[j * 64 + lane]); A *= a; H = a * H + BQ[j * 64 + lane];
            oAL[(size_t)j * 256] = (bf16)f2bf(A); oHL[(size_t)j * 256] = (bf16)f2bf(H); }
        WSP(float, WS_LR_AE)[((size_t)d * NBLK + blk) * 256 + c] = A; WSP(float, WS_LR_HE)[((size_t)d * NBLK + blk) * 256 + c] = H;
    }
    WAVE_LDS_SYNC();
}
__device__ __forceinline__ void phase_prep(const Ctx& C, int l) {
    const int gw = C.wg * NWAVES + C.wave, NGW = C.G * NWAVES;
#pragma unroll 1
    for (int j = gw; j < (MT / 8) * 4; j += NGW) prep_rw(C, l, j);
#pragma unroll 1
    for (int j = gw; j < NBLK * 12; j += NGW) prep_ss(C, l, j);
#pragma unroll 1
    for (int j = gw; j < NBLK * 8; j += NGW) prep_lr(C, l, j);
#pragma unroll 1
    for (int j = gw; j < NBLK * 8; j += NGW) prep_hg(C, l, j);
}

constexpr int SC_Y = 49152;
__device__ __forceinline__ v4u ld16(const bf16* p) { return *(const GAS v4u*)p; }
#define STEP_TOKEN(cc, s) (d ? (T - 1 - ((cc) * 32 + (s))) : ((cc) * 32 + (s)))
__device__ __forceinline__ void flush_y(const Ctx& C, bf16* ydst, int cc, int d, int T) {
    const LAS float* Y = (const LAS float*)(C.lds + SC_Y);
    const int s = C.tid >> 4, pr = C.tid & 15; const int t = STEP_TOKEN(cc, s);
    *(GAS unsigned*)(ydst + (size_t)t * 256 + 2 * pr) = pk2(Y[s * 32 + 2 * pr], Y[s * 32 + 2 * pr + 1]);
}
__device__ __forceinline__ void scan_rwkv(const Ctx& C, int l, int lat, int b, int d, int h, int rb) {
    const int tid = C.tid, row = tid >> 4, q = tid & 15;
    const int T = lat ? TL : TC, ms = lat ? MC + b * TL : b * TC, nch = T / 32;
    LAS float* LW = (LAS float*)C.lds; LAS float* LKK = LW + 2048; LAS float* LB_ = LW + 4096; LAS float* LKD = LW + 6144; LAS float* LR = LW + 8192; LAS float* LV = LW + 10240; LAS float* LY = (LAS float*)(C.lds + SC_Y);
    const int hi = tid >> 8, p = tid & 255, ps = p >> 3, pp = p & 7;
    const size_t doff = (size_t)d * MT * 256;
    const bf16* a0 = (hi ? WSP(const bf16, WS_RW_KK) : WSP(const bf16, WS_RW_E) + doff) + (size_t)ms * 256 + h * 64 + pp * 8;
    const bf16* a1 = (hi ? WSP(const bf16, WS_RW_KD) + doff : WSP(const bf16, WS_RW_B) + doff) + (size_t)ms * 256 + h * 64 + pp * 8;
    const bf16* a2 = hi ? WSP(const bf16, WS_RW_V) + (size_t)ms * 256 + h * 64 + rb * 32 + (p & 3) * 8 : WSP(const bf16, WS_RW_R) + (size_t)ms * 256 + h * 64 + pp * 8;
    const int s2 = hi ? (p >> 2) : ps; const bool do2 = !hi || p < 128;
    LAS float* d0 = (hi ? LKK : LW) + ps * 64 + pp * 8; LAS float* d1 = (hi ? LKD : LB_) + ps * 64 + pp * 8; LAS float* d2 = hi ? LV + (p >> 2) * 32 + (p & 3) * 8 : LR + ps * 64 + pp * 8;
    float S0, S1, S2, S3;
    const int v = rb * 32 + row;
    if (lat) { const f4 s = *(const GAS f4*)(INP(I_SRW) + ((((size_t)(b * 4 + l) * 2 + d) * 4 + h) * 64 + v) * 64 + 4 * q); S0 = s.x; S1 = s.y; S2 = s.z; S3 = s.w; }
    else { S0 = S1 = S2 = S3 = 0.f; }
    bf16* ydst = WSP(bf16, WS_YS) + ((size_t)d * MT + ms) * 256 + h * 64 + rb * 32;
    v4u pf0, pf1, pf2 = (v4u){0u, 0u, 0u, 0u};
    { pf0 = ld16(a0 + (size_t)STEP_TOKEN(0, ps) * 256); pf1 = ld16(a1 + (size_t)STEP_TOKEN(0, ps) * 256); if (do2) pf2 = ld16(a2 + (size_t)STEP_TOKEN(0, s2) * 256); }
    const LAS f4* pW = (const LAS f4*)LW + q; const LAS f4* pKK = (const LAS f4*)LKK + q; const LAS f4* pB = (const LAS f4*)LB_ + q; const LAS f4* pKD = (const LAS f4*)LKD + q; const LAS f4* pR = (const LAS f4*)LR + q;
#define RW_LOAD(X, s) f4 w##X = pW[(s) * 16], kk##X = pKK[(s) * 16], bv##X = pB[(s) * 16], kd##X = pKD[(s) * 16], r##X = pR[(s) * 16]; float vv##X = LV[(s) * 32 + row];
#define RW_STEP(X, s) { const float sa = -sum16((S0 * kk##X.x + S1 * kk##X.y) + (S2 * kk##X.z + S3 * kk##X.w)); \
        S0 = S0 * w##X.x + (sa * bv##X.x + vv##X * kd##X.x); S1 = S1 * w##X.y + (sa * bv##X.y + vv##X * kd##X.y); S2 = S2 * w##X.z + (sa * bv##X.z + vv##X * kd##X.z); S3 = S3 * w##X.w + (sa * bv##X.w + vv##X * kd##X.w); \
        const float yp = sum16((S0 * r##X.x + S1 * r##X.y) + (S2 * r##X.z + S3 * r##X.w)); ykeep = (((s) & 15) == q) ? yp : ykeep; }
#pragma unroll 1
    for (int cc = 0; cc < nch; ++cc) {
        { float o[8]; cvt8(pf0, o); if (!hi) {
#pragma unroll
                for (int i = 0; i < 8; ++i) o[i] = __expf(-o[i]); }
            st8(d0, o); cvt8(pf1, o); st8(d1, o); if (do2) { cvt8(pf2, o); st8(d2, o); } }
        __syncthreads();
        if (cc + 1 < nch) { pf0 = ld16(a0 + (size_t)STEP_TOKEN(cc + 1, ps) * 256); pf1 = ld16(a1 + (size_t)STEP_TOKEN(cc + 1, ps) * 256); if (do2) pf2 = ld16(a2 + (size_t)STEP_TOKEN(cc + 1, s2) * 256); }
        float ykeep = 0.f;
#pragma unroll
        for (int s = 0; s < 32; s += 4) {
            RW_LOAD(A, s) RW_LOAD(B, s + 1)
            RW_STEP(A, s)
            RW_LOAD(C_, s + 2)
            RW_STEP(B, s + 1)
            RW_LOAD(D, s + 3)
            RW_STEP(C_, s + 2)
            RW_STEP(D, s + 3)
            if ((s & 15) == 12) LY[((s & 16) + q) * 32 + row] = ykeep;
        }
        __syncthreads();
        flush_y(C, ydst, cc, d, T);
    }
#undef RW_LOAD
#undef RW_STEP
    if (!lat) *(GAS f4*)(C.out + O_SRW + ((((size_t)(b * 4 + l) * 2 + d) * 4 + h) * 64 + v) * 64 + 4 * q) = (f4){S0, S1, S2, S3};
}

__device__ __forceinline__ bf16x8 mk8(v2u lo, v2u hi) { v4u w; w.x = lo.x; w.y = lo.y; w.z = hi.x; w.w = hi.y; return __builtin_bit_cast(bf16x8, w); }
__device__ __forceinline__ v2u pk4(const f32x4 v) { v2u w; w.x = pk2(v[0], v[1]); w.y = pk2(v[2], v[3]); return w; }
__device__ __forceinline__ v2u pk4h(const f32x4 v) { v2u w; w.x = pg8::cvt_pk_bf16(v[0], v[1]); w.y = pg8::cvt_pk_bf16(v[2], v[3]); return w; }
__device__ __forceinline__ v2u lds8(const LAS unsigned char* p) { return *(const LAS v2u*)p; }
constexpr int HG_ROW = 144;
constexpr int HG_QT = 0, HG_KD = 16 * HG_ROW, HG_KT = 2 * 16 * HG_ROW, HG_VT = HG_KT + 2048, HG_G = HG_VT + 2048, HG_DSZ = HG_G + 256, HG_BUF = 2 * HG_DSZ;
static_assert(HG_DSZ % 16 == 0 && 2 * HG_BUF <= SC_Y, "hg lds");
__device__ __forceinline__ void hg_job(const Ctx& C, int l, int lat, int b, int h) {
    const int tid = C.tid, lane = C.lane, c = lane & 15, g = lane >> 4, d = C.wave >> 2, vt = C.wave & 3;
    const int T = lat ? TL : TC, ms = lat ? MC + b * TL : b * TC, nb = T / 16, blk0 = ms / 16;
    bf16* YO = WSP(bf16, WS_YS) + (size_t)2 * MT * 256 + h * 64 + vt * 16 + c;
    const int ld = tid >> 8, q = tid & 255, qa_ = q & 127;
    const bf16* gA = (q < 128 ? WSP(const bf16, WS_HG_QT) : WSP(const bf16, WS_HG_KD)) + (size_t)ld * MT * 256 + h * 64 + (qa_ >> 3) * 256 + (qa_ & 7) * 8;
    const bf16* gB = q < 128 ? WSP(const bf16, WS_HG_KT) + ((size_t)ld * NBLK * 256 + h * 64) * 16 + qa_ * 8 : WSP(const bf16, WS_HG_VT) + (size_t)(h * 64) * 16 + qa_ * 8;
    const float* gG = WSP(const float, WS_HG_G) + (size_t)ld * NBLK * 256 + h * 64 + (q & 15) * 4;
    const int oA = ld * HG_DSZ + (q < 128 ? HG_QT : HG_KD) + (qa_ >> 3) * HG_ROW + (qa_ & 7) * 16, oB = ld * HG_DSZ + (q < 128 ? HG_KT : HG_VT) + qa_ * 16, oG = ld * HG_DSZ + HG_G + (q & 15) * 16;
    f32x4 st[4];
#pragma unroll
    for (int kt = 0; kt < 4; ++kt) {
        if (lat) { const GAS float* sp = INP(I_SHG) + ((((size_t)(b * 4 + l) * 2 + d) * 4 + h) * 64 + 16 * kt + 4 * g) * 64 + vt * 16 + c; st[kt] = (f32x4){sp[0], sp[64], sp[128], sp[192]}; }
        else st[kt] = (f32x4){0.f, 0.f, 0.f, 0.f};
    }
    v4u rA, rB; f4 rG = (f4){0.f, 0.f, 0.f, 0.f};
    { const int blk = ld ? nb - 1 : 0; const size_t gb = (size_t)blk0 + blk; rA = ld16(gA + gb * 16 * 256); rB = ld16(gB + gb * 4096); if (q < 16) rG = *(const GAS f4*)(gG + gb * 256); }
#pragma unroll 1
    for (int ib = 0; ib < nb; ++ib) {
        LAS unsigned char* buf = C.lds + (ib & 1) * HG_BUF;
        *(LAS v4u*)(buf + oA) = rA; *(LAS v4u*)(buf + oB) = rB; if (q < 16) *(LAS f4*)(buf + oG) = rG;
        __syncthreads();
        if (ib + 1 < nb) { const int blk = ld ? nb - 2 - ib : ib + 1; const size_t gb = (size_t)blk0 + blk; rA = ld16(gA + gb * 16 * 256); rB = ld16(gB + gb * 4096); if (q < 16) rG = *(const GAS f4*)(gG + gb * 256); }
        const int blk = d ? nb - 1 - ib : ib; const size_t m0 = (size_t)ms + blk * 16;
        const LAS unsigned char* bd = buf + d * HG_DSZ;
        f32x4 acc = (f32x4){0.f, 0.f, 0.f, 0.f}, sT = (f32x4){0.f, 0.f, 0.f, 0.f};
        unsigned short oo[4];
        const bool rmw = ib >= (nb >> 1);
        if (rmw) {
#pragma unroll
            for (int rg = 0; rg < 4; ++rg) oo[rg] = YO[(m0 + 4 * g + rg) * 256]; }
#pragma unroll
        for (int kap = 0; kap < 2; ++kap) {
            const bf16x8 qa = mk8(lds8(bd + HG_QT + c * HG_ROW + (32 * kap + 4 * g) * 2), lds8(bd + HG_QT + c * HG_ROW + (32 * kap + 16 + 4 * g) * 2));
            const bf16x8 ka = mk8(lds8(bd + HG_KD + c * HG_ROW + (32 * kap + 4 * g) * 2), lds8(bd + HG_KD + c * HG_ROW + (32 * kap + 16 + 4 * g) * 2));
            acc = __builtin_amdgcn_mfma_f32_16x16x32_bf16(qa, mk8(pk4h(st[2 * kap]), pk4h(st[2 * kap + 1])), acc, 0, 0, 0);
            sT = __builtin_amdgcn_mfma_f32_16x16x32_bf16(ka, qa, sT, 0, 0, 0);
        }
#pragma unroll
        for (int rg = 0; rg < 4; ++rg) { const int s = 4 * g + rg; const bool keep = d ? (s >= c) : (s <= c); sT[rg] = keep ? sT[rg] : 0.f; }
        const bf16x8 Bv = mk8(lds8(buf + (d ? HG_DSZ : 0) + HG_VT + (vt * 16 + c) * 32 + 8 * g), (v2u){0u, 0u});
        acc = __builtin_amdgcn_mfma_f32_16x16x32_bf16(mk8(pk4h(sT), (v2u){0u, 0u}), Bv, acc, 0, 0, 0);
#pragma unroll
        for (int rg = 0; rg < 4; ++rg) { float o = acc[rg]; if (rmw) o += bf2f(oo[rg]); YO[(m0 + 4 * g + rg) * 256] = (bf16)f2bf(o); }
#pragma unroll
        for (int kt = 0; kt < 4; ++kt) { const f4 gv = *(const LAS f4*)(bd + HG_G + (16 * kt + 4 * g) * 4); f32x4 s = st[kt]; s[0] *= gv.x; s[1] *= gv.y; s[2] *= gv.z; s[3] *= gv.w;
            st[kt] = __builtin_amdgcn_mfma_f32_16x16x32_bf16(mk8(lds8(bd + HG_KT + (16 * kt + c) * 32 + 8 * g), (v2u){0u, 0u}), Bv, s, 0, 0, 0); }
    }
    if (!lat) {
#pragma unroll
        for (int kt = 0; kt < 4; ++kt) { GAS float* sp = (GAS float*)(C.out + O_SHG + ((((size_t)(b * 4 + l) * 2 + d) * 4 + h) * 64 + 16 * kt + 4 * g) * 64 + vt * 16 + c); sp[0] = st[kt][0]; sp[64] = st[kt][1]; sp[128] = st[kt][2]; sp[192] = st[kt][3]; }
    }
    __syncthreads();
}
constexpr int SS_ROW = 272;
constexpr int SS_C = 0, SS_B = 16 * SS_ROW, SS_BT = 2 * 16 * SS_ROW, SS_XT = SS_BT + 4096, SS_XW = SS_XT + 2048, SS_CI = SS_XW + 2048, SS_GG = SS_CI + 64, SS_DTV = SS_GG + 16, SS_DSZ = SS_DTV + 64, SS_BUF = 2 * SS_DSZ;
static_assert(SS_DSZ % 16 == 0 && 2 * SS_BUF <= 131072, "ss lds");
__device__ __forceinline__ void ss_job(const Ctx& C, int l, int lat, int b, int h) {
    const int tid = C.tid, lane = C.lane, c = lane & 15, g = lane >> 4, d = C.wave >> 2, pt = C.wave & 3, grp = h >> 1;
    const int T = lat ? TL : TC, ms = lat ? MC + b * TL : b * TC, nb = T / 16, blk0 = ms / 16;
    bf16* YO = WSP(bf16, WS_YS) + (size_t)3 * MT * 256 + h * 64 + pt * 16 + c;
    const float Dh = INP(I_SSD)[l * 4 + h];
    const int ld = tid >> 8, q = tid & 255, qh = q & 127;
    const bf16* gC = WSP(const bf16, WS_SS_C) + grp * 128 + (q >> 4) * 256 + (q & 15) * 8;
    const bf16* gBn = WSP(const bf16, WS_SS_B) + grp * 128 + (q >> 4) * 256 + (q & 15) * 8;
    const bf16* gBT = WSP(const bf16, WS_SS_BT) + (size_t)(grp * 128) * 16 + q * 8;
    const bf16* gX = (q < 128 ? WSP(const bf16, WS_SS_XT) : WSP(const bf16, WS_SS_XWT)) + ((size_t)ld * NBLK * 256 + h * 64) * 16 + qh * 8;
    const float* gS = q < 4 ? WSP(const float, WS_SS_CIN) + ((size_t)ld * NBLK * 4 + h) * 16 + q * 4 : (q < 8 ? WSP(const float, WS_SS_DT) + (size_t)h * 16 + (q - 4) * 4 : WSP(const float, WS_SS_G) + (size_t)ld * NBLK * 4 + h);
    const int oC = ld * SS_DSZ + SS_C + (q >> 4) * SS_ROW + (q & 15) * 16, oBn = ld * SS_DSZ + SS_B + (q >> 4) * SS_ROW + (q & 15) * 16, oBT = ld * SS_DSZ + SS_BT + q * 16,
              oX = ld * SS_DSZ + (q < 128 ? SS_XT : SS_XW) + qh * 16, oS = ld * SS_DSZ + (q < 4 ? SS_CI + q * 16 : (q < 8 ? SS_DTV + (q - 4) * 16 : SS_GG));
    f32x4 st[8];
#pragma unroll
    for (int nt = 0; nt < 8; ++nt) {
        if (lat) st[nt] = *(const GAS f32x4*)(INP(I_SSS) + ((((size_t)(b * 4 + l) * 2 + d) * 4 + h) * 64 + pt * 16 + c) * 128 + 16 * nt + 4 * g);
        else st[nt] = (f32x4){0.f, 0.f, 0.f, 0.f};
    }
    v4u rC, rBn, rBT, rX; f4 rS = (f4){0.f, 0.f, 0.f, 0.f};
#define SS_FETCH(blk_) do { const size_t gb_ = (size_t)blk0 + (blk_); rC = ld16(gC + gb_ * 16 * 256); rBn = ld16(gBn + gb_ * 16 * 256); rBT = ld16(gBT + gb_ * 4096); rX = ld16(gX + gb_ * 4096); \
        if (q < 8) rS = *(const GAS f4*)(gS + gb_ * 64); else if (q == 8) rS.x = gS[gb_ * 4]; } while (0)
    SS_FETCH(ld ? nb - 1 : 0);
#pragma unroll 1
    for (int ib = 0; ib < nb; ++ib) {
        LAS unsigned char* buf = C.lds + (ib & 1) * SS_BUF;
        *(LAS v4u*)(buf + oC) = rC; *(LAS v4u*)(buf + oBn) = rBn; *(LAS v4u*)(buf + oBT) = rBT; *(LAS v4u*)(buf + oX) = rX;
        if (q < 8) *(LAS f4*)(buf + oS) = rS; else if (q == 8) *(LAS float*)(buf + oS) = rS.x;
        __syncthreads();
        if (ib + 1 < nb) SS_FETCH(ld ? nb - 2 - ib : ib + 1);
        const int blk = d ? nb - 1 - ib : ib; const size_t m0 = (size_t)ms + blk * 16;
        const LAS unsigned char* bd = buf + d * SS_DSZ;
        f32x4 acc = (f32x4){0.f, 0.f, 0.f, 0.f}, sT = (f32x4){0.f, 0.f, 0.f, 0.f};
        unsigned short oo[4];
        const bool rmw = ib >= (nb >> 1);
        if (rmw) {
#pragma unroll
            for (int rg = 0; rg < 4; ++rg) oo[rg] = YO[(m0 + 4 * g + rg) * 256]; }
#pragma unroll
        for (int kap = 0; kap < 4; ++kap) {
            const bf16x8 ca = mk8(lds8(bd + SS_C + c * SS_ROW + (32 * kap + 4 * g) * 2), lds8(bd + SS_C + c * SS_ROW + (32 * kap + 16 + 4 * g) * 2));
            const bf16x8 ba = mk8(lds8(bd + SS_B + c * SS_ROW + (32 * kap + 4 * g) * 2), lds8(bd + SS_B + c * SS_ROW + (32 * kap + 16 + 4 * g) * 2));
            acc = __builtin_amdgcn_mfma_f32_16x16x32_bf16(ca, mk8(pk4h(st[2 * kap]), pk4h(st[2 * kap + 1])), acc, 0, 0, 0);
            sT = __builtin_amdgcn_mfma_f32_16x16x32_bf16(ba, ca, sT, 0, 0, 0);
        }
        const f4 cin4 = *(const LAS f4*)(bd + SS_CI + 16 * g); const float cint = *(const LAS float*)(bd + SS_CI + 4 * c), gg = *(const LAS float*)(bd + SS_GG);
        acc[0] *= __expf(cin4.x); acc[1] *= __expf(cin4.y); acc[2] *= __expf(cin4.z); acc[3] *= __expf(cin4.w);
#pragma unroll
        for (int rg = 0; rg < 4; ++rg) { const int s = 4 * g + rg; const bool keep = d ? (s >= c) : (s <= c); const float e = __expf(fminf(cint - cin4[rg], 0.f)); sT[rg] = keep ? sT[rg] * e : 0.f; }
        const v2u xt = lds8(bd + SS_XT + (pt * 16 + c) * 32 + 8 * g);
        acc = __builtin_amdgcn_mfma_f32_16x16x32_bf16(mk8(pk4h(sT), (v2u){0u, 0u}), mk8(xt, (v2u){0u, 0u}), acc, 0, 0, 0);
        f4 dt4 = (f4){1.f, 1.f, 1.f, 1.f}; if (d == 0) dt4 = *(const LAS f4*)(buf + SS_DTV + 16 * g);
#pragma unroll
        for (int rg = 0; rg < 4; ++rg) { float o = acc[rg];
            if (d == 0) { const unsigned w = rg < 2 ? xt.x : xt.y; const float xd = (rg & 1) ? bfhi(w) : bflo(w); o += Dh * xd / dt4[rg]; }
            if (rmw) o += bf2f(oo[rg]);
            YO[(m0 + 4 * g + rg) * 256] = (bf16)f2bf(o); }
        const bf16x8 Bw = mk8(lds8(bd + SS_XW + (pt * 16 + c) * 32 + 8 * g), (v2u){0u, 0u});
#pragma unroll
        for (int nt = 0; nt < 8; ++nt) st[nt] = __builtin_amdgcn_mfma_f32_16x16x32_bf16(mk8(lds8(bd + SS_BT + (16 * nt + c) * 32 + 8 * g), (v2u){0u, 0u}), Bw, st[nt] * gg, 0, 0, 0);
    }
#undef SS_FETCH
    if (!lat) {
#pragma unroll
        for (int nt = 0; nt < 8; ++nt) *(GAS f32x4*)(C.out + O_SSS + ((((size_t)(b * 4 + l) * 2 + d) * 4 + h) * 64 + pt * 16 + c) * 128 + 16 * nt + 4 * g) = st[nt];
    }
    __syncthreads();
}
__device__ __forceinline__ void lr_wave(const Ctx& C, int l, int job) {
    const int cb = job & 3, d = (job >> 2) & 1, sq = job >> 3, lat = sq >= 32, b = lat ? sq - 32 : sq, c = cb * 64 + C.lane;
    const int T = lat ? TL : TC, ms = lat ? MC + b * TL : b * TC, nb = T / 16, blk0 = ms / 16;
    const float* AE = WSP(const float, WS_LR_AE) + ((size_t)d * NBLK + blk0) * 256 + c; const float* HE = WSP(const float, WS_LR_HE) + ((size_t)d * NBLK + blk0) * 256 + c;
    float* HIN = WSP(float, WS_LR_HIN) + ((size_t)d * NBLK + blk0) * 256 + c;
    float hs = lat ? INP(I_SLR)[((size_t)(b * 4 + l) * 2 + d) * 256 + c] : 0.f;
#pragma unroll 1
    for (int i0 = 0; i0 < nb; i0 += 8) {
        float a[8], e[8];
#pragma unroll
        for (int i = 0; i < 8; ++i) { const int blk = d ? nb - 1 - (i0 + i) : i0 + i; a[i] = AE[(size_t)blk * 256]; e[i] = HE[(size_t)blk * 256]; }
#pragma unroll
        for (int i = 0; i < 8; ++i) { const int blk = d ? nb - 1 - (i0 + i) : i0 + i; HIN[(size_t)blk * 256] = hs; hs = a[i] * hs + e[i]; }
    }
    if (!lat) C.out[O_SLR + ((size_t)(b * 4 + l) * 2 + d) * 256 + c] = hs;
}

__device__ __forceinline__ void run_job(const Ctx& C0, int l, int kind, int id) {
    Ctx C = C0; { int t_ = C0.tid; asm volatile("" : "+v"(t_)); C.tid = t_; C.lane = t_ & 63; C.wave = __builtin_amdgcn_readfirstlane(t_ >> 6); }
#ifndef JOBEN
#define JOBEN 7
#endif
    if (kind == 0) { if (!(JOBEN & 1)) return; const int lt = id >= 512 ? 1 : 0; id -= lt * 512; scan_rwkv(C, l, lt, id >> 4, (id >> 3) & 1, (id >> 1) & 3, id & 1); }
    else { const int lt = id >= 128 ? 1 : 0; id -= lt * 128; if (kind == 1) { if (JOBEN & 2) ss_job(C, l, lt, id >> 2, id & 3); } else { if (JOBEN & 4) hg_job(C, l, lt, id >> 2, id & 3); } }
}
__device__ __forceinline__ void phase_scans(const Ctx& C, int l) {
    int w = C.wg; asm volatile("" : "+s"(w)); const int G = C.G;
    { const int gw = (w >= 64 ? w - 64 : w + G - 64) * NWAVES + C.wave;
#pragma unroll 1
      for (int j = gw; j < 288; j += G * NWAVES) lr_wave(C, l, j); }
    if (G == 256) {
#pragma unroll 1
        for (int i = 0; i < 5; ++i) {
            int kind = -1, id = 0;
            if (w < 64) { if (i == 0) { kind = 0; id = 512 + w; } }
            else if (w < 96) { const int x = w - 64; if (i == 0) { kind = 1 + (x >> 4); id = 128 + (x & 15); } else if (i == 1) { kind = 0; id = 480 + x; } }
            else { const int k = w - 96; if (i < 3) { kind = 0; id = k + 160 * i; } else { const int e = k + 160 * (i - 3); if (e < 256) { kind = 1 + (e >> 7); id = e & 127; } } }
            kind = __builtin_amdgcn_readfirstlane(kind); id = __builtin_amdgcn_readfirstlane(id);
            asm volatile("" : "+s"(kind), "+s"(id));
            if (kind >= 0) run_job(C, l, kind, id);
        }
    } else {
#pragma unroll 1
        for (int j = w; j < 576 + 288; j += G) { int kind = j < 576 ? 0 : (j < 720 ? 1 : 2), id = j < 576 ? j : (j < 720 ? j - 576 : j - 720); kind = __builtin_amdgcn_readfirstlane(kind); id = __builtin_amdgcn_readfirstlane(id); asm volatile("" : "+s"(kind), "+s"(id)); run_job(C, l, kind, id); }
    }
}

__device__ __forceinline__ void ld4bf(const bf16* p, float (&o)[4]) { const unsigned long long w = *(const GAS unsigned long long*)p; o[0] = bflo((unsigned)w); o[1] = bfhi((unsigned)w); o[2] = bflo((unsigned)(w >> 32)); o[3] = bfhi((unsigned)(w >> 32)); }
__device__ __forceinline__ void st4bf(bf16* p, const float (&o)[4]) { *(GAS unsigned long long*)p = (unsigned long long)pk2(o[0], o[1]) | ((unsigned long long)pk2(o[2], o[3]) << 32); }
__device__ __forceinline__ void phase_post(const Ctx& C, int l) {
    const int gw = C.wg * NWAVES + C.wave, NGW = C.G * NWAVES, lane = C.lane, c4 = 4 * lane, h = lane >> 4;
    const bf16* YS = WSP(const bf16, WS_YS); const bf16* PROJ = WSP(const bf16, WS_PROJ); bf16* MIX = WSP(bf16, WS_MIX);
    const f4 lnw = *(const GAS f4*)(INP(I_RWLNW) + l * 256 + c4), lnb = *(const GAS f4*)(INP(I_RWLNB) + l * 256 + c4), hgn = *(const GAS f4*)(INP(I_HGNORM) + l * 256 + c4), ssn = *(const GAS f4*)(INP(I_SSNORM) + l * 256 + c4);
    const size_t YA = (size_t)MT * 256;
#pragma unroll 1
    for (int m = gw; m < MT; m += NGW) {
        const size_t mo = (size_t)m * 256 + c4; const size_t gb = (size_t)(m >> 4); float a[4], b[4], o[4];
        { ld4bf(YS + 0 * YA + mo, a); ld4bf(YS + 1 * YA + mo, b); float y[4], s = 0.f;
#pragma unroll
          for (int i = 0; i < 4; ++i) { y[i] = a[i] + b[i]; s += y[i]; }
          const float mean = sum16(s) * (1.f / 64.f); float qv = 0.f;
#pragma unroll
          for (int i = 0; i < 4; ++i) { y[i] -= mean; qv += y[i] * y[i]; }
          const float rs = rsqrtf(sum16(qv) * (1.f / 64.f) + 64e-5f);
          float vv[4], gg[4]; ld4bf(WSP(const bf16, WS_RW_V) + mo, vv); ld4bf(WSP(const bf16, WS_RW_G) + mo, gg);
          const float bon = WSP(const float, WS_RW_BON)[(size_t)m * 4 + h];
#pragma unroll
          for (int i = 0; i < 4; ++i) o[i] = (y[i] * rs * lnw[i] + lnb[i] + bon * vv[i]) * gg[i];
          st4bf(MIX + (size_t)m * DM + c4, o); }
        { ld4bf(YS + 2 * YA + mo, a); float s = 0.f;
#pragma unroll
          for (int i = 0; i < 4; ++i) s += a[i] * a[i];
          const float rs = rsqrtf(wave_sum(s) * (1.f / 256.f) + 1e-6f);
          float gp[4]; ld4bf(PROJ + (size_t)m * PINP + C_HG_G + c4, gp);
#pragma unroll
          for (int i = 0; i < 4; ++i) o[i] = a[i] * rs * hgn[i] * siluf_(gp[i]);
          st4bf(MIX + (size_t)m * DM + 256 + c4, o); }
        { ld4bf(YS + 3 * YA + mo, a); float zz[4], y[4], s = 0.f; ld4bf(PROJ + (size_t)m * PINP + C_SS_Z + c4, zz);
#pragma unroll
          for (int i = 0; i < 4; ++i) { y[i] = a[i] * siluf_(zz[i]); s += y[i] * y[i]; }
          const float rs = rsqrtf(wave_sum(s) * (1.f / 256.f) + 1e-6f);
#pragma unroll
          for (int i = 0; i < 4; ++i) o[i] = y[i] * rs * ssn[i];
          st4bf(MIX + (size_t)m * DM + 512 + c4, o); }
        { float al[4], hl[4], yb[4]; ld4bf(PROJ + (size_t)m * PINP + C_LR_Y + c4, yb);
          const f4 h0 = *(const GAS f4*)(WSP(const float, WS_LR_HIN) + gb * 256 + c4), h1 = *(const GAS f4*)(WSP(const float, WS_LR_HIN) + ((size_t)NBLK + gb) * 256 + c4);
          ld4bf(WSP(const bf16, WS_LR_AL) + mo, al); ld4bf(WSP(const bf16, WS_LR_HL) + mo, hl);
#pragma unroll
          for (int i = 0; i < 4; ++i) o[i] = al[i] * h0[i] + hl[i];
          ld4bf(WSP(const bf16, WS_LR_AL) + YA + mo, al); ld4bf(WSP(const bf16, WS_LR_HL) + YA + mo, hl);
#pragma unroll
          for (int i = 0; i < 4; ++i) o[i] = (o[i] + al[i] * h1[i] + hl[i]) * gelu_tanh(yb[i]);
          st4bf(MIX + (size_t)m * DM + 768 + c4, o); }
    }
}

struct Args { const float* in[N_IN]; float* out; unsigned char* ws; int ph_lo, ph_hi; };
constexpr int N_PHASES = 2 + 9 * DEPTH;
#ifndef MKEN
#define MKEN 0xFFFF
#endif
#define EN(x) ((MKEN >> (x)) & 1)

__global__ void __launch_bounds__(NWAVES * 64, 2) mk_fwd(Args args) {
    extern __shared__ __attribute__((aligned(16))) unsigned char lds_raw[];
    Ctx C;
    C.out = args.out; C.ws = args.ws;
    C.lds = (LAS unsigned char*)lds_raw;
    C.tid = threadIdx.x; C.lane = C.tid & 63; C.wave = __builtin_amdgcn_readfirstlane(C.tid >> 6);
    C.G = gridDim.x; C.wg = blockIdx.x;
    volatile LAS unsigned* MISC = (volatile LAS unsigned*)(C.lds + MISC_OFF);
    for (int u = C.tid; u < (LDS_BYTES - LDSCTL_OFF) / 4; u += NWAVES * 64) ((LAS unsigned*)(C.lds + LDSCTL_OFF))[u] = 0u;
    __syncthreads();
    if (C.tid == 0) {
#pragma unroll
        for (int i = 0; i < N_IN; ++i) *(LAS unsigned long long*)(C.lds + PTAB_OFF + 8 * i) = (unsigned long long)args.in[i];
    }
    __syncthreads();
    const int lo = args.ph_lo, hi = args.ph_hi;
    XcdBarrier bar; bar.bar = (unsigned*)(C.ws + WS_CTL) + CW_BAR; bar.x = 0; bar.st = nullptr;
    if (hi - lo > 1) bar = xcd_barrier_post((unsigned*)(C.ws + WS_CTL) + CW_BAR, MISC + 8);
#define IN(k) (lo <= (k) && (k) < hi)
#define SEAM(k) do { if (IN(k) && IN((k) + 1)) xcd_barrier(bar); RELAUNDER(); } while (0)
#define RELAUNDER() do { int t_ = threadIdx.x; asm volatile("" : "+v"(t_)); C.tid = t_; C.lane = t_ & 63; C.wave = __builtin_amdgcn_readfirstlane(t_ >> 6); } while (0)
    if (EN(0) && IN(0)) { for (int rep = 0; rep < NREP(0); ++rep) p0_prologue(C); } SEAM(0);
    if (EN(1) && IN(1)) { phase_norm_in(C); } SEAM(1);
#pragma unroll 1
    for (int l = 0; l < DEPTH; ++l) {
        const int p0 = 2 + 9 * l;
        if (EN(2) && IN(p0 + 0)) {
            pg8::Gemm g{WSP(const bf16, WS_H), WSP(const bf16, WS_WIN) + (size_t)l * PINP * DM, MT, PINP, DM}; pg8::StaticOrder S; S.init(MT, PINP, C.G, C.wg);
            pg8::EpiBf16<0> E{WSP(bf16, WS_PROJ), PINP};
            for (int rep = 0; rep < NREP(2); ++rep) pg8::gemm_phase<pg8::EpiBf16<0>, pg8::StaticOrder, PG8_ALIGN, PG8_SP2>(C.lds, g, S, E);
        } SEAM(p0 + 0);
        if (EN(3) && IN(p0 + 1)) { for (int rep = 0; rep < NREP(3); ++rep) phase_prep(C, l); } SEAM(p0 + 1);
        if (EN(4) && IN(p0 + 2)) { for (int rep = 0; rep < NREP(4); ++rep) phase_scans(C, l); } SEAM(p0 + 2);
        if (EN(5) && IN(p0 + 3)) { for (int rep = 0; rep < NREP(5); ++rep) phase_post(C, l); } SEAM(p0 + 3);
        if (EN(6) && IN(p0 + 4)) {
            pg8::Gemm g{WSP(const bf16, WS_MIX), WSP(const bf16, WS_WOUT) + (size_t)l * DM * DM, MT, DM, DM}; pg8::StaticOrder S; S.init(MT, DM, C.G, C.wg);
            pg8::EpiF32 E{WSP(float, WS_GO), DM};
            for (int rep = 0; rep < NREP(2); ++rep) pg8::gemm_phase<pg8::EpiF32, pg8::StaticOrder, PG8_ALIGN, PG8_SP2>(C.lds, g, S, E);
        } SEAM(p0 + 4);
        if (EN(7) && IN(p0 + 5)) { phase_norm_res(C, l, 0); } SEAM(p0 + 5);
        if (EN(8) && IN(p0 + 6)) {
            pg8::Gemm g{WSP(const bf16, WS_H), WSP(const bf16, WS_W1) + (size_t)l * FFD * DM, MT, FFD, DM}; pg8::StaticOrder S; S.init(MT, FFD, C.G, C.wg);
            pg8::EpiBf16<2> E{WSP(bf16, WS_U), FFD};
            for (int rep = 0; rep < NREP(2); ++rep) pg8::gemm_phase<pg8::EpiBf16<2>, pg8::StaticOrder, PG8_ALIGN, PG8_SP2>(C.lds, g, S, E);
        } SEAM(p0 + 6);
        if (EN(9) && IN(p0 + 7)) {
            pg8::Gemm g{WSP(const bf16, WS_U), WSP(const bf16, WS_W2) + (size_t)l * DM * FFD, MT, DM, FFD}; pg8::StaticOrder S; S.init(MT, DM, C.G, C.wg);
            pg8::EpiF32 E{WSP(float, WS_GO), DM};
            for (int rep = 0; rep < NREP(2); ++rep) pg8::gemm_phase<pg8::EpiF32, pg8::StaticOrder, PG8_ALIGN, PG8_SP2>(C.lds, g, S, E);
        } SEAM(p0 + 7);
        if (EN(10) && IN(p0 + 8)) { phase_norm_res(C, l, 1); } SEAM(p0 + 8);
    }
#undef IN
#undef SEAM
}

extern "C" void kernel_launch(void* const* d_in, const int* in_sizes, int n_in, void* d_out, int out_size, void* d_ws, size_t ws_size, hipStream_t stream) {
    static int grid = 0;
    if (grid == 0) {
        if (n_in != N_IN || (size_t)out_size != O_END || ws_size < WS_END) { fprintf(stderr, "kernel_launch: unexpected shapes: n_in %d out %d ws %zu (need %zu)\n", n_in, out_size, ws_size, (size_t)WS_END); grid = -1; return; }
        int dev = 0, cus = 0, per_cu = 0;
        if (hipGetDevice(&dev) != hipSuccess || hipDeviceGetAttribute(&cus, hipDeviceAttributeMultiprocessorCount, dev) != hipSuccess) { grid = -1; return; }
        if (hipFuncSetAttribute((const void*)mk_fwd, hipFuncAttributeMaxDynamicSharedMemorySize, LDS_BYTES) != hipSuccess) { fprintf(stderr, "kernel_launch: hipFuncSetAttribute failed\n"); grid = -1; return; }
        if (hipOccupancyMaxActiveBlocksPerMultiprocessor(&per_cu, (const void*)mk_fwd, NWAVES * 64, LDS_BYTES) != hipSuccess || per_cu < 1) { fprintf(stderr, "kernel_launch: occupancy query says %d blocks per CU\n", per_cu); (void)hipGetLastError(); grid = -1; return; }
        grid = cus;
    }
    if (grid < 0) return;
    if (hipMemsetAsync((char*)d_ws + WS_CTL, 0, CTL_ZERO_BYTES, stream) != hipSuccess) return;
    Args a{};
    for (int i = 0; i < N_IN; ++i) a.in[i] = (const float*)d_in[i];
    a.out = (float*)d_out; a.ws = (unsigned char*)d_ws;
#if MK_SINGLE
    a.ph_lo = 0; a.ph_hi = N_PHASES;
    void* kargs[] = {&a};
    hipError_t e = hipLaunchCooperativeKernel((const void*)mk_fwd, dim3(grid), dim3(NWAVES * 64), kargs, LDS_BYTES, stream);
    if (e != hipSuccess) fprintf(stderr, "kernel_launch: cooperative launch failed: %s (grid %d)\n", hipGetErrorString(e), grid);
#else
    for (int p = 0; p < N_PHASES; ++p) { a.ph_lo = p; a.ph_hi = p + 1; hipLaunchKernelGGL(mk_fwd, dim3(grid), dim3(NWAVES * 64), LDS_BYTES, stream, a); }
#endif
}
```

```cpp
#include <hip/hip_runtime.h>
#include <cstdio>
#include <cstdint>
namespace pg8 {
#define PG8_LAS __attribute__((address_space(3)))
typedef unsigned short bf16_t;
typedef short bf16x8 __attribute__((ext_vector_type(8)));
typedef float f32x4 __attribute__((ext_vector_type(4)));
typedef unsigned u32x4 __attribute__((ext_vector_type(4)));
constexpr int BM = 256, BK = 64, HALF = 128, HTB = HALF * BK * 2  , STAGE_BYTES = 8 * HTB, NXCD = 8, WGM = 8;

__host__ __device__ __forceinline__ int lds_byte(int r, int c) { const int st = (r >> 4) * 2 + (c >> 5), rr = r & 15, cc = c & 31, ob = rr * 64 + cc * 2; return st * 1024 + (ob ^ (((ob >> 9) & 1) << 5)); }
__host__ __device__ __forceinline__ void stage_rc(int b, int& R, int& C) { const int st = b / 1024, sb = b % 1024, swz = sb ^ (((sb >> 9) & 1) << 5); R = (st >> 1) * 16 + swz / 64; C = (st & 1) * 32 + (swz % 64) / 2; }
__host__ __device__ __forceinline__ int perm32(int rho) { const int n = rho >> 4, i = rho & 15; return 8 * (i >> 2) + 4 * n + (i & 3); }

struct Unit { int pm, pn; };
struct Gemm { const bf16_t* A; const bf16_t* Bt; int M, N, K; };

struct StaticOrder {
    int nM, nN, nwg, G, c;
    __host__ __device__ void init(int M, int N, int G_, int c_) { nM = M / BM; nN = N / BM; nwg = nM * nN; G = G_; c = c_; }
    __host__ __device__ bool next(int i, Unit& u) const {
        const long L = (long)i * G + c; if (L >= nwg) return false;
        int wgid = (int)L; { const int q = nwg / NXCD, r = nwg % NXCD, xcd = wgid % NXCD, off = wgid / NXCD; wgid = (xcd < r ? xcd * (q + 1) : r * (q + 1) + (xcd - r) * q) + off; }
        const int nig = WGM * nN, gid = wgid / nig, fm = gid * WGM, gsz = (nM - fm) < WGM ? (nM - fm) : WGM;
        u.pm = fm + ((wgid % nig) % gsz); u.pn = (wgid % nig) / gsz; return true;
    }
    __device__ __forceinline__ void a_ready(const Unit&) const {}
    __device__ __forceinline__ void done(const Unit&) const {}
};

__device__ __forceinline__ unsigned cvt_pk_bf16(float lo, float hi) { unsigned r; asm volatile("v_cvt_pk_bf16_f32 %0, %1, %2" : "=v"(r) : "v"(lo), "v"(hi)); return r; }
typedef float f32x2 __attribute__((ext_vector_type(2)));
__device__ __forceinline__ f32x2 gelu_pk(f32x2 v) {
    const f32x2 av = __builtin_elementwise_abs(v), d = av * 0.2316418882f + 1.0f;
    f32x2 t; t.x = __builtin_amdgcn_rcpf(d.x); t.y = __builtin_amdgcn_rcpf(d.y);
    f32x2 q = t * 0.5307027145f + (-0.7265760135f); q = q * t + 0.7107068705f; q = q * t + (-0.142248368f); q = q * t + 0.127414796f; q = q * t;
    const f32x2 s = (v * v) * (-0.72134752044f);
    f32x2 e; e.x = __builtin_amdgcn_exp2f(s.x); e.y = __builtin_amdgcn_exp2f(s.y);
    const f32x2 m = v * (q * e), r = v - m;
    f32x2 o; o.x = v.x < 0.f ? m.x : r.x; o.y = v.y < 0.f ? m.y : r.y; return o;
}

template <int ACT  > struct EpiBf16 {
    static constexpr bool PERM = true, AFTER_DRAIN = false;
    bf16_t* O; int ldc;
    __device__ __forceinline__ void operator()(const f32x4 (&acc)[2][2][4][2], const Unit& u, int wr, int wc, int fr, int fq) const {
        const int row0 = u.pm * BM + wr * 64 + fr; const int col0 = u.pn * BM + wc * 32 + 8 * fq;
#pragma unroll
        for (int ai = 0; ai < 2; ++ai)
#pragma unroll
            for (int m = 0; m < 4; ++m) { bf16_t* rowp = O + (size_t)(row0 + ai * HALF + m * 16) * ldc + col0;
#pragma unroll
                for (int bj = 0; bj < 2; ++bj) { f32x4 v0 = acc[ai][bj][m][0], v1 = acc[ai][bj][m][1];
                    if (ACT == 2) {
#pragma unroll
                        for (int e = 0; e < 4; ++e) { float a = fmaxf(v0[e], 0.f), b = fmaxf(v1[e], 0.f); v0[e] = a * a; v1[e] = b * b; } }
                    u32x4 w; w.x = cvt_pk_bf16(v0[0], v0[1]); w.y = cvt_pk_bf16(v0[2], v0[3]); w.z = cvt_pk_bf16(v1[0], v1[1]); w.w = cvt_pk_bf16(v1[2], v1[3]);
                    *(u32x4*)(rowp + bj * HALF) = w; } }
    }
};
struct EpiF32 {
    static constexpr bool PERM = false, AFTER_DRAIN = false;
    float* O; int ldc;
    __device__ __forceinline__ void operator()(const f32x4 (&acc)[2][2][4][2], const Unit& u, int wr, int wc, int fr, int fq) const {
        const int col0 = u.pn * BM + wc * 32 + 4 * fq;
#pragma unroll
        for (int ai = 0; ai < 2; ++ai)
#pragma unroll
            for (int m = 0; m < 4; ++m) { const size_t off = (size_t)(u.pm * BM + ai * HALF + wr * 64 + m * 16 + fr) * ldc + col0;
#pragma unroll
                for (int bj = 0; bj < 2; ++bj)
#pragma unroll
                    for (int n = 0; n < 2; ++n) *(f32x4*)(O + off + bj * HALF + n * 16) = acc[ai][bj][m][n]; }
    }
};
template <class Epi, class Sched, bool ALIGN_EPI = false, bool SP2 = false>
__device__ __forceinline__ void gemm_phase(PG8_LAS unsigned char* lds, const Gemm g, const Sched& S, const Epi& E) {
    int tid_ = threadIdx.x; asm volatile("" : "+v"(tid_));
    const int tid = tid_, wid = __builtin_amdgcn_readfirstlane(tid >> 6), lane = tid & 63, wr = wid >> 2, wc = wid & 3, fr = lane & 15, fq = lane >> 4;
    const int K = g.K, nt = K / BK;
    unsigned voffA[2], voffB[2];
#pragma unroll
    for (int i = 0; i < 2; ++i) { int R, C; stage_rc(tid * 16 + i * 8192, R, C); const int Rb = Epi::PERM ? ((R & ~31) + perm32(R & 31)) : R;
        voffA[i] = (unsigned)(R * K + C) * 2u; voffB[i] = (unsigned)(Rb * K + C) * 2u; }
    const size_t kstep = (size_t)(BK * 2);
    const size_t hstep = (size_t)HALF * K * 2;
    const size_t tstep = 2 * hstep;
    const unsigned ldsw = (unsigned)wid * 1024u;
    const int aoff = lds_byte(wr * 64 + fr, fq * 8), boff = lds_byte(wc * 32 + fr, fq * 8);
#define PG8_SA(b, h) (((b) * 2 + (h)) * HTB)
#define PG8_SB(b, h) ((4 + (b) * 2 + (h)) * HTB)
#define PG8_STAGE(bufoff, gbase, voff) do { _Pragma("unroll") for (int _i = 0; _i < 2; ++_i) \
        __builtin_amdgcn_global_load_lds((const unsigned*)((const char*)(gbase) + (voff)[_i]), (PG8_LAS unsigned*)(lds + (bufoff) + ldsw + _i * 8192), 16, 0, 0); } while (0)
#define PG8_LDA(dst, b, h) do { _Pragma("unroll") for (int m = 0; m < 4; ++m) _Pragma("unroll") for (int k = 0; k < 2; ++k) dst[m][k] = *(const PG8_LAS bf16x8*)(lds + PG8_SA(b, h) + aoff + m * 2048 + k * 1024); } while (0)
#define PG8_LDB(dst, b, h) do { _Pragma("unroll") for (int n = 0; n < 2; ++n) _Pragma("unroll") for (int k = 0; k < 2; ++k) dst[n][k] = *(const PG8_LAS bf16x8*)(lds + PG8_SB(b, h) + boff + n * 2048 + k * 1024); } while (0)
#define PG8_MMA(ai, bj, At, Bt) do { __builtin_amdgcn_s_setprio(1); _Pragma("unroll") for (int m = 0; m < 4; ++m) _Pragma("unroll") for (int n = 0; n < 2; ++n) _Pragma("unroll") for (int k = 0; k < 2; ++k) \
        acc[ai][bj][m][n] = __builtin_amdgcn_mfma_f32_16x16x32_bf16(Bt[n][k], At[m][k], acc[ai][bj][m][n], 0, 0, 0); __builtin_amdgcn_s_setprio(0); } while (0)
#define PG8_WAIT_V(n) asm volatile("s_waitcnt vmcnt(" #n ")" ::: "memory")
#define PG8_WAIT_L(n) asm volatile("s_waitcnt lgkmcnt(" #n ")" ::: "memory")
#define PG8_BAR __builtin_amdgcn_s_barrier()
#define PG8_SCHED __builtin_amdgcn_sched_barrier(0)
    Unit cur, nxt; int ui = 0;
    if (!S.next(0, cur)) return;
    f32x4 acc[2][2][4][2];
#pragma unroll
    for (int a = 0; a < 2; ++a)
#pragma unroll
        for (int b = 0; b < 2; ++b)
#pragma unroll
            for (int m = 0; m < 4; ++m)
#pragma unroll
                for (int n = 0; n < 2; ++n) acc[a][b][m][n] = (f32x4){0.f, 0.f, 0.f, 0.f};
    bf16x8 At[4][2], B0[2][2], B1[2][2];
    const char* cA = (const char*)g.A + (size_t)cur.pm * tstep; const char* cB = (const char*)g.Bt + (size_t)cur.pn * tstep;
    S.a_ready(cur);
    if constexpr (SP2) {
        PG8_STAGE(PG8_SB(0, 0), cB, voffB); PG8_STAGE(PG8_SB(0, 1), cB + hstep, voffB); PG8_STAGE(PG8_SA(0, 0), cA, voffA); PG8_STAGE(PG8_SA(0, 1), cA + hstep, voffA);
        if (wr == 1) PG8_BAR;
        PG8_WAIT_V(2); PG8_BAR;
        PG8_STAGE(PG8_SB(1, 0), cB + kstep, voffB); PG8_STAGE(PG8_SA(1, 0), cA + kstep, voffA); PG8_STAGE(PG8_SB(1, 1), cB + hstep + kstep, voffB);
        PG8_WAIT_V(6); PG8_BAR;
    } else {
        PG8_STAGE(PG8_SB(0, 0), cB, voffB); PG8_STAGE(PG8_SA(0, 0), cA, voffA); PG8_STAGE(PG8_SB(0, 1), cB + hstep, voffB); PG8_STAGE(PG8_SA(0, 1), cA + hstep, voffA);
        if (wr == 1) PG8_BAR;
        PG8_WAIT_V(4); PG8_BAR;
        PG8_STAGE(PG8_SB(1, 0), cB + kstep, voffB); PG8_STAGE(PG8_SA(1, 0), cA + kstep, voffA); PG8_STAGE(PG8_SB(1, 1), cB + hstep + kstep, voffB);
        PG8_WAIT_V(6); PG8_BAR;
    }
    for (;;) {
        const bool has_next = S.next(ui + 1, nxt);
        const char* nA = has_next ? (const char*)g.A + (size_t)nxt.pm * tstep : cA; const char* nB = has_next ? (const char*)g.Bt + (size_t)nxt.pn * tstep : cB;
        for (int t = 0; t < nt; t += 2) {
            const bool last = (t == nt - 2);
            const char* a1 = cA + (size_t)(t + 1) * kstep;
            const char* a2 = last ? nA : cA + (size_t)(t + 2) * kstep; const char* b2 = last ? nB : cB + (size_t)(t + 2) * kstep;
            const char* a3 = a2 + kstep; const char* b3 = b2 + kstep;
            if (last && has_next) S.a_ready(nxt);
            if constexpr (SP2) {
            PG8_LDB(B0, 0, 0); PG8_LDB(B1, 0, 1); PG8_SCHED; PG8_LDA(At, 0, 0); PG8_STAGE(PG8_SA(1, 1), a1 + hstep, voffA);
            PG8_WAIT_V(8); PG8_WAIT_L(0); PG8_BAR; PG8_MMA(0, 0, At, B0); PG8_MMA(0, 1, At, B1); PG8_BAR; PG8_SCHED;
            PG8_LDA(At, 0, 1); PG8_STAGE(PG8_SB(0, 0), b2, voffB); PG8_STAGE(PG8_SB(0, 1), b2 + hstep, voffB); PG8_STAGE(PG8_SA(0, 0), a2, voffA);
            PG8_WAIT_V(8); PG8_WAIT_L(0); PG8_BAR; PG8_MMA(1, 0, At, B0); PG8_MMA(1, 1, At, B1); PG8_BAR; PG8_SCHED;
            PG8_LDB(B0, 1, 0); PG8_LDB(B1, 1, 1); PG8_SCHED; PG8_LDA(At, 1, 0); PG8_STAGE(PG8_SA(0, 1), a2 + hstep, voffA);
            PG8_WAIT_V(8); PG8_WAIT_L(0); PG8_BAR; PG8_MMA(0, 0, At, B0); PG8_MMA(0, 1, At, B1); PG8_BAR; PG8_SCHED;
            PG8_LDA(At, 1, 1); PG8_STAGE(PG8_SB(1, 0), b3, voffB); PG8_STAGE(PG8_SB(1, 1), b3 + hstep, voffB); PG8_STAGE(PG8_SA(1, 0), a3, voffA);
            PG8_WAIT_V(8); PG8_WAIT_L(0); PG8_BAR; PG8_MMA(1, 0, At, B0); PG8_MMA(1, 1, At, B1); PG8_BAR; PG8_SCHED;
            } else {
            PG8_LDB(B0, 0, 0); PG8_SCHED; PG8_LDA(At, 0, 0); PG8_STAGE(PG8_SA(1, 1), a1 + hstep, voffA);
            PG8_WAIT_L(8); PG8_BAR; PG8_WAIT_L(0); PG8_MMA(0, 0, At, B0); PG8_BAR; PG8_SCHED;
            PG8_LDB(B1, 0, 1); PG8_STAGE(PG8_SB(0, 0), b2, voffB);
            PG8_BAR; PG8_WAIT_L(0); PG8_MMA(0, 1, At, B1); PG8_BAR;
            PG8_LDA(At, 0, 1); PG8_STAGE(PG8_SA(0, 0), a2, voffA);
            PG8_BAR; PG8_WAIT_L(0); PG8_MMA(1, 0, At, B0); PG8_BAR; PG8_SCHED;
            PG8_STAGE(PG8_SB(0, 1), b2 + hstep, voffB);
            PG8_WAIT_V(6); PG8_BAR; PG8_MMA(1, 1, At, B1); PG8_BAR;
            PG8_LDB(B0, 1, 0); PG8_SCHED; PG8_LDA(At, 1, 0); PG8_STAGE(PG8_SA(0, 1), a2 + hstep, voffA);
            PG8_WAIT_L(8); PG8_BAR; PG8_WAIT_L(0); PG8_MMA(0, 0, At, B0); PG8_BAR; PG8_SCHED;
            PG8_LDB(B1, 1, 1); PG8_STAGE(PG8_SB(1, 0), b3, voffB);
            PG8_BAR; PG8_WAIT_L(0); PG8_MMA(0, 1, At, B1); PG8_BAR;
            PG8_LDA(At, 1, 1); PG8_STAGE(PG8_SA(1, 0), a3, voffA);
            PG8_BAR; PG8_WAIT_L(0); PG8_MMA(1, 0, At, B0); PG8_BAR; PG8_SCHED;
            PG8_STAGE(PG8_SB(1, 1), b3 + hstep, voffB);
            PG8_WAIT_V(6); PG8_BAR; PG8_MMA(1, 1, At, B1); PG8_BAR;
            }
        }
        if constexpr (ALIGN_EPI) { if (wr == 0) PG8_BAR; }
        if constexpr (!Epi::AFTER_DRAIN) { E(acc, cur, wr, wc, fr, fq); S.done(cur); }
        if (!has_next) break;
#pragma unroll
        for (int a = 0; a < 2; ++a)
#pragma unroll
            for (int b = 0; b < 2; ++b)
#pragma unroll
                for (int m = 0; m < 4; ++m)
#pragma unroll
                    for (int n = 0; n < 2; ++n) acc[a][b][m][n] = (f32x4){0.f, 0.f, 0.f, 0.f};
        cur = nxt; cA = nA; cB = nB; ++ui;
        if constexpr (ALIGN_EPI) { if (wr == 1) PG8_BAR; }
    }
    PG8_WAIT_V(0);
    if constexpr (!ALIGN_EPI) { if (wr == 0) PG8_BAR; }
    PG8_BAR;
    if constexpr (Epi::AFTER_DRAIN) { E.fused(acc, cur, wr, wc, fr, fq, lds, wid, lane); S.done(cur); }
#undef PG8_SA
#undef PG8_SB
#undef PG8_STAGE
#undef PG8_LDA
#undef PG8_LDB
#undef PG8_MMA
#undef PG8_WAIT_V
#undef PG8_WAIT_L
#undef PG8_BAR
#undef PG8_SCHED
}
}

#ifndef PG8_SP2
#define PG8_SP2 true
#endif
#ifndef PG8_ALIGN
#define PG8_ALIGN true
#endif
#if defined(__HIP_DEVICE_COMPILE__)
#define GAS __attribute__((address_space(1)))
#else
#define GAS
#endif
#define LAS __attribute__((address_space(3)))
typedef unsigned short bf16;
typedef unsigned v4u __attribute__((ext_vector_type(4)));
typedef float f32x4 __attribute__((ext_vector_type(4)));
typedef short bf16x8 __attribute__((ext_vector_type(8)));
typedef GAS unsigned gu32;
typedef GAS unsigned long long gu64;
#define RLX_AGENT __ATOMIC_RELAXED, __HIP_MEMORY_SCOPE_AGENT
#define LDS_WAIT() asm volatile("s_waitcnt lgkmcnt(0)" ::: "memory")
#define VM_WAIT() asm volatile("s_waitcnt vmcnt(0)" ::: "memory")
__device__ __forceinline__ unsigned long long rt() { return __builtin_amdgcn_s_memrealtime(); }
__device__ __forceinline__ unsigned f2bf(float f) { unsigned u = __builtin_bit_cast(unsigned, f); return (u + 0x7fffu + ((u >> 16) & 1u)) >> 16; }
__device__ __forceinline__ unsigned pk2(float lo, float hi) { return f2bf(lo) | (f2bf(hi) << 16); }

#define XB_TMO      128
#define XB_XCNT(j)  (256  + 64 * (j))
#define XB_XSUB(j)  (1280 + 64 * (j))
#define XB_XGEN(j)  (2304 + 64 * (j))
#define XB_TOP      3328
#define XB_TOPGEN   3392
#define XCD_BAR_WORDS 3456
#define XB_SPIN_CAP (1u << 18)

__device__ __forceinline__ unsigned xb_ld(unsigned* p)              { return __hip_atomic_load(p, __ATOMIC_RELAXED, __HIP_MEMORY_SCOPE_AGENT); }
__device__ __forceinline__ unsigned xb_add(unsigned* p, unsigned v) { return __hip_atomic_fetch_add(p, v, __ATOMIC_RELAXED, __HIP_MEMORY_SCOPE_AGENT); }
__device__ __forceinline__ unsigned xb_xcc_id() { return (unsigned)__builtin_amdgcn_s_getreg((3 << 11) | 20) & 0xFu; }
#define XB_SPIN(cond, bar) do { unsigned _sp = 0; while (cond) { __builtin_amdgcn_s_sleep(1); \
    if ((++_sp & 255u) == 0u) { if (xb_ld(&(bar)[XB_TMO])) break; if (_sp > XB_SPIN_CAP) { atomicAdd(&(bar)[XB_TMO], 1u); break; } } } } while (0)

struct XcdBarrier {
    unsigned* bar; unsigned x;
    volatile LAS unsigned* st;
};

__device__ __forceinline__ XcdBarrier xcd_barrier_post(unsigned* bar, volatile LAS unsigned* st) {
    XcdBarrier b; b.bar = bar; b.x = xb_xcc_id(); b.st = st;
    if (threadIdx.x == 0) (void)xb_add(&bar[XB_XCNT(b.x)], 1u);
    return b;
}
__device__ __forceinline__ void xcd_barrier_complete(unsigned* bar, unsigned x, unsigned& nloc, unsigned& nx) {
    const unsigned G = gridDim.x * gridDim.y * gridDim.z;
    unsigned sum, cnt, mine, sp = 0u;
    for (;;) {
        sum = 0u; cnt = 0u; mine = 0u;
#pragma unroll
        for (unsigned j = 0; j < 16; ++j) { const unsigned c = xb_ld(&bar[XB_XCNT(j)]); sum += c; cnt += (c > 0u) ? 1u : 0u; mine = (j == x) ? c : mine; }
        if (sum == G) break;
        __builtin_amdgcn_s_sleep(1);
        if ((++sp & 255u) == 0u) { if (xb_ld(&bar[XB_TMO])) break; if (sp > XB_SPIN_CAP) { atomicAdd(&bar[XB_TMO], 1u); break; } }
    }
    nloc = mine > 0u ? mine : 1u; nx = cnt > 0u ? cnt : 1u;
}

__device__ __forceinline__ void xcd_barrier(const XcdBarrier& b) {
    asm volatile("s_waitcnt vmcnt(0)" ::: "memory");
    __syncthreads();
    if (threadIdx.x == 0) {
        unsigned* bar = b.bar;
        __builtin_amdgcn_s_waitcnt(0);
        unsigned nloc = b.st[0], nx = b.st[1];
        if (nloc == 0u) { xcd_barrier_complete(bar, b.x, nloc, nx); b.st[0] = nloc; b.st[1] = nx; }
        const unsigned old = xb_add(&bar[XB_XSUB(b.x)], 1u);
        const unsigned gen = old / nloc;
        if (old + 1u == (gen + 1u) * nloc) {
            __builtin_amdgcn_fence(__ATOMIC_RELEASE, "agent");
            asm volatile("s_waitcnt vmcnt(0)" ::: "memory");
            const unsigned og = xb_add(&bar[XB_TOP], 1u);
            const unsigned tg = og / nx;
            if (og + 1u == (tg + 1u) * nx) xb_add(&bar[XB_TOPGEN], 1u);
            else XB_SPIN(xb_ld(&bar[XB_TOPGEN]) == tg, bar);
            __builtin_amdgcn_fence(__ATOMIC_ACQUIRE, "agent");
            xb_add(&bar[XB_XGEN(b.x)], 1u);
            asm volatile("s_waitcnt vmcnt(0)" ::: "memory");
        } else {
            XB_SPIN(xb_ld(&bar[XB_XGEN(b.x)]) == gen, bar);
            __builtin_amdgcn_fence(__ATOMIC_ACQUIRE, "agent");
            asm volatile("s_waitcnt vmcnt(0)" ::: "memory");
        }
    }
    __syncthreads();
}
#ifndef MK_SINGLE
#define MK_SINGLE 1
#endif
constexpr int NWAVES = 8;
constexpr int DM = 1024, MT = 12288, MC = 8192, DEPTH = 4, PIN = 3688, PINP = 3840, FFD = 4096;
constexpr int TC = 256, TL = 1024;
constexpr int C_RW_WD = 768, C_RW_AD = 800, C_RW_GD = 832, RWC = 864;
constexpr int C_HG_Q = 864, C_HG_I = 1120, C_HG_F = 1376, C_HG_G = 1888;
constexpr int C_SS_Z = 2144, C_SS_XBC = 2400, C_SS_DT = 3168;
constexpr int C_LR_Y = 3176, C_LR_X = 3432;
enum { I_XP = 0, I_XS, I_SRW, I_SHG, I_SSS, I_SLR, I_C, I_CCTX, I_MODW, I_MODB, I_NORMG, I_WIN, I_WOUT, I_RWMU, I_RWW0, I_RWW2, I_RWA0, I_RWA2, I_RWG2, I_RWKK, I_RWKA, I_RWRK,
       I_RWLNW, I_RWLNB, I_HGLB, I_HGNORM, I_SSCW, I_SSCB, I_SSDTB, I_SSALOG, I_SSD, I_SSNORM, I_LRCW, I_LRCB, I_LRWA, I_LRBA, I_LRWX, I_LRBX, I_LRLAM, I_W1, I_W2, N_IN };
constexpr size_t O_X = 0, O_SRW = 12582912, O_SHG = 16777216, O_SSS = 20971520, O_SLR = 29360128, O_END = 29425664;
constexpr size_t MiB = 1u << 20;
constexpr size_t WS_CTL = 0, CTL_ZERO_BYTES = 1 * MiB;
constexpr size_t WS_MOD = 1 * MiB;
constexpr size_t WS_LB = 1 * MiB + 512 * 1024;
constexpr size_t WS_WLR = 2 * MiB;
constexpr size_t WS_WIN = 3 * MiB;
constexpr size_t WS_WOUT = 33 * MiB;
constexpr size_t WS_W1 = 41 * MiB;
constexpr size_t WS_W2 = 73 * MiB;
constexpr size_t WS_PROJ = 105 * MiB;
constexpr size_t WS_U = WS_PROJ;
constexpr size_t A6 = 6 * MiB;
constexpr int NBLK = MT / 16;
constexpr size_t WS_RW_R = 195 * MiB, WS_RW_V = WS_RW_R + A6, WS_RW_G = WS_RW_V + A6, WS_RW_E = WS_RW_G + A6  , WS_RW_KK = WS_RW_E + 2 * A6, WS_RW_KD = WS_RW_KK + A6  ,
                 WS_RW_B = WS_RW_KD + 2 * A6  , WS_RW_BON = WS_RW_B + 2 * A6  ;
constexpr size_t WS_MIX = WS_RW_KK;
constexpr size_t WS_HG_QT = WS_RW_BON + 1 * MiB  , WS_HG_KD = WS_HG_QT + 2 * A6  , WS_HG_KT = WS_HG_KD + 2 * A6  , WS_HG_VT = WS_HG_KT + 2 * A6  ,
                 WS_HG_G = WS_HG_VT + A6  ;
constexpr size_t WS_SS_B = WS_HG_G + 2 * MiB, WS_SS_C = WS_SS_B + A6, WS_SS_BT = WS_SS_C + A6, WS_SS_XT = WS_SS_BT + A6  , WS_SS_XWT = WS_SS_XT + 2 * A6  ,
                 WS_SS_CIN = WS_SS_XWT + 2 * A6  , WS_SS_G = WS_SS_CIN + 512 * 1024  , WS_SS_DT = WS_SS_CIN + 768 * 1024  ;
constexpr size_t WS_LR_AL = WS_SS_CIN + 1 * MiB  , WS_LR_HL = WS_LR_AL + 2 * A6  , WS_LR_AE = WS_LR_HL + 2 * A6  , WS_LR_HE = WS_LR_AE + 2 * MiB, WS_LR_HIN = WS_LR_HE + 2 * MiB;
constexpr size_t WS_YS = WS_LR_HIN + 2 * MiB;
constexpr size_t WS_END = WS_YS + 4 * A6;
constexpr size_t WS_H = WS_HG_QT;
constexpr size_t WS_GO = WS_SS_B;
static_assert(WS_RW_BON == 255 * MiB && WS_HG_QT == 256 * MiB && WS_SS_B == 300 * MiB && WS_LR_AL == 343 * MiB && WS_YS == 373 * MiB && WS_END == 397 * MiB, "ws map");
static_assert(WS_U + 96 * MiB <= WS_RW_V && WS_MIX + 24 * MiB <= WS_RW_BON && WS_H + 24 * MiB <= WS_HG_KT && WS_GO + 48 * MiB <= WS_LR_AL + 6 * MiB, "overlays");
constexpr int CW_BAR = 4096;
constexpr int RING_BYTES = 131072, LDSCTL_OFF = RING_BYTES, MISC_OFF = LDSCTL_OFF + 320, LDS_BYTES = 147456;

#ifndef REPMASK
#define REPMASK 0
#endif
#define NREP(x) (((REPMASK >> (x)) & 1) ? 2 : 1)
typedef float f4 __attribute__((ext_vector_type(4)));
typedef float f2 __attribute__((ext_vector_type(2)));
__device__ __forceinline__ float bf2f(bf16 v) { return __uint_as_float((unsigned)v << 16); }
__device__ __forceinline__ float bflo(unsigned w) { return __uint_as_float(w << 16); }
__device__ __forceinline__ float bfhi(unsigned w) { return __uint_as_float(w & 0xffff0000u); }
__device__ __forceinline__ float sigmoidf_(float x) { return 1.f / (1.f + __expf(-x)); }
__device__ __forceinline__ float siluf_(float x) { return x / (1.f + __expf(-x)); }
__device__ __forceinline__ float softplusf_(float x) { return x > 20.f ? x : log1pf(__expf(x)); }
__device__ __forceinline__ float gelu_tanh(float x) { const float u = 0.7978845608028654f * (x + 0.044715f * x * x * x); return 0.5f * x * (1.f + tanhf(u)); }
__device__ __forceinline__ float wave_sum(float v) {
#pragma unroll
    for (int o = 1; o < 64; o <<= 1) v += __shfl_xor(v, o);
    return v;
}
template <int CTRL> __device__ __forceinline__ float dppf(float v) {
    return __builtin_bit_cast(float, __builtin_amdgcn_update_dpp(0, __builtin_bit_cast(int, v), CTRL, 0xF, 0xF, true));
}
__device__ __forceinline__ float sum16(float v) {
    v += dppf<0xB1>(v); v += dppf<0x4E>(v); v += dppf<0x141>(v); v += dppf<0x140>(v); return v;
}
__device__ __forceinline__ void cvt8(const v4u w, float (&o)[8]) {
    o[0] = bflo(w.x); o[1] = bfhi(w.x); o[2] = bflo(w.y); o[3] = bfhi(w.y); o[4] = bflo(w.z); o[5] = bfhi(w.z); o[6] = bflo(w.w); o[7] = bfhi(w.w);
}
__device__ __forceinline__ void st8(LAS float* p, const float (&o)[8]) { *(LAS f4*)p = (f4){o[0], o[1], o[2], o[3]}; *(LAS f4*)(p + 4) = (f4){o[4], o[5], o[6], o[7]}; }

struct Ctx {
    float* out; unsigned char* ws;
    int tid, lane, wave, G, wg;
    LAS unsigned char* lds;
};
constexpr int PTAB_OFF = 131584;
typedef const GAS float* gcf;
__device__ __forceinline__ gcf ldptr(const Ctx& C, int i) {
    const LAS unsigned* t = (const LAS unsigned*)(C.lds + PTAB_OFF) + 2 * i;
    const unsigned lo = __builtin_amdgcn_readfirstlane(t[0]), hi = __builtin_amdgcn_readfirstlane(t[1]);
    return (gcf)(((unsigned long long)hi << 32) | (unsigned long long)lo);
}
#define INP(i) ldptr(C, (i))
#define WSP(T, off) ((GAS T*)(C.ws + (off)))

__device__ __forceinline__ void tr_item(const float* W, int K, int N, int Np, bf16* WT, LAS float* scr, int item, int lane) {
    const int nblk = Np / 32, kb = item / nblk, nb = item % nblk, k0 = 64 * kb, n0 = 32 * nb;
    const int nn = n0 + (lane & 31); const bool ok = nn < N;
#pragma unroll 8
    for (int i = 0; i < 32; ++i) { const int kk = 2 * i + (lane >> 5); scr[kk * 33 + (lane & 31)] = ok ? W[(size_t)(k0 + kk) * N + nn] : 0.f; }
    LDS_WAIT(); asm volatile("" ::: "memory");
    const int c = lane & 7;
#pragma unroll
    for (int j = 0; j < 4; ++j) { const int n = (lane >> 3) + 8 * j; const LAS float* s = scr + (8 * c) * 33 + n;
        v4u o; o.x = pk2(s[0 * 33], s[1 * 33]); o.y = pk2(s[2 * 33], s[3 * 33]); o.z = pk2(s[4 * 33], s[5 * 33]); o.w = pk2(s[6 * 33], s[7 * 33]);
        *(GAS v4u*)(WT + (size_t)(n0 + n) * K + k0 + 8 * c) = o; }
    LDS_WAIT(); asm volatile("" ::: "memory");
}
__device__ __forceinline__ void p0_prologue(const Ctx& C) {
    const int gw = C.wg * NWAVES + C.wave, NGW = C.G * NWAVES;
    {
        LAS float* scr = (LAS float*)(C.lds + C.wave * 16384);
        constexpr int I_IN = 16 * (PINP / 32), I_OUT = 16 * 32, I_1 = 16 * (FFD / 32), I_2 = 64 * 32, I_L = I_IN + I_OUT + I_1 + I_2;
        for (int it = gw; it < DEPTH * I_L; it += NGW) {
            const int l = it / I_L; int r = it - l * I_L;
            if (r < I_IN) { tr_item(INP(I_WIN) + (size_t)l * DM * PIN, DM, PIN, PINP, WSP(bf16, WS_WIN) + (size_t)l * PINP * DM, scr, r, C.lane); continue; } r -= I_IN;
            if (r < I_OUT) { tr_item(INP(I_WOUT) + (size_t)l * DM * DM, DM, DM, DM, WSP(bf16, WS_WOUT) + (size_t)l * DM * DM, scr, r, C.lane); continue; } r -= I_OUT;
            if (r < I_1) { tr_item(INP(I_W1) + (size_t)l * DM * FFD, DM, FFD, FFD, WSP(bf16, WS_W1) + (size_t)l * FFD * DM, scr, r, C.lane); continue; } r -= I_1;
            tr_item(INP(I_W2) + (size_t)l * FFD * DM, FFD, DM, DM, WSP(bf16, WS_W2) + (size_t)l * DM * FFD, scr, r, C.lane);
        }
    }
    {
        bf16* WLR = WSP(bf16, WS_WLR);
        for (int o = C.wg * 512 + C.tid; o < DEPTH * 2 * 2 * 4 * 64 * 64; o += C.G * 512) {
            const int i = o & 63, j = (o >> 6) & 63, h = (o >> 12) & 3, g = (o >> 14) & 1, d = (o >> 15) & 1, l = o >> 16;
            const float* src = g ? INP(I_LRWX) : INP(I_LRWA);
            WLR[o] = (bf16)f2bf(src[((((size_t)l * 2 + d) * 4 + h) * 64 + i) * 64 + j]);
        }
    }
    {
        float* LB = WSP(float, WS_LB);
        for (int o = C.wg * 512 + C.tid; o < 512; o += C.G * 512) {
            float v[4], mx = -1e30f;
#pragma unroll
            for (int l = 0; l < 4; ++l) { v[l] = INP(I_HGLB)[l * 512 + o]; mx = fmaxf(mx, v[l]); }
            float s = 0.f;
#pragma unroll
            for (int l = 0; l < 4; ++l) { v[l] = expf(v[l] - mx); s += v[l]; }
            const float inv = 1.f / s; float cum = 0.f;
#pragma unroll
            for (int l = 0; l < 4; ++l) { const float p = v[l] * inv; cum += p; LB[l * 512 + o] = cum - v[0] * inv; }
        }
    }
    __syncthreads();
    {
        LAS float* SC = (LAS float*)C.lds;
        LAS float* RED = SC + 5 * 1024;
        bool staged = false;
        for (int u = C.wg; u < DEPTH * 48; u += C.G) {
            if (!staged) {
                for (int e = C.tid; e < 5 * 1024; e += 512) { const int cnd = e >> 10, k = e & 1023; const float x = cnd == 0 ? INP(I_CCTX)[k] : INP(I_C)[(cnd - 1) * 1024 + k]; SC[e] = siluf_(x); }
                staged = true;
            }
            __syncthreads();
            const int l = u / 48, j0 = (u % 48) * 128 + 2 * C.lane;
            const float* wp = INP(I_MODW) + (size_t)l * DM * 6144 + j0;
            float acc[5][2];
#pragma unroll
            for (int cnd = 0; cnd < 5; ++cnd) { acc[cnd][0] = 0.f; acc[cnd][1] = 0.f; }
            const int kb = C.wave * 128;
#pragma unroll 8
            for (int k = kb; k < kb + 128; ++k) { const f2 w = *(const f2*)(wp + (size_t)k * 6144);
#pragma unroll
                for (int cnd = 0; cnd < 5; ++cnd) { const float s = SC[cnd * 1024 + k]; acc[cnd][0] += s * w.x; acc[cnd][1] += s * w.y; } }
#pragma unroll
            for (int cnd = 0; cnd < 5; ++cnd) { RED[(C.wave * 5 + cnd) * 128 + 2 * C.lane] = acc[cnd][0]; RED[(C.wave * 5 + cnd) * 128 + 2 * C.lane + 1] = acc[cnd][1]; }
            __syncthreads();
            for (int e = C.tid; e < 5 * 128; e += 512) { const int cnd = e >> 7, j = e & 127; float s = 0.f;
#pragma unroll
                for (int w = 0; w < 8; ++w) s += RED[(w * 5 + cnd) * 128 + j];
                const int col = (u % 48) * 128 + j;
                WSP(float, WS_MOD)[((size_t)l * 5 + cnd) * 6144 + col] = s + INP(I_MODB)[l * 6144 + col]; }
        }
        __syncthreads();
    }
}

__device__ __forceinline__ const float* mod_row(const Ctx& C, int l, int m) { const int cnd = m < MC ? 0 : 1 + ((m - MC) >> 10); return WSP(const float, WS_MOD) + ((size_t)l * 5 + cnd) * 6144; }
__device__ __forceinline__ void write_h(const Ctx& C, const f4 (&x)[4], float ssq, const float* g, const float* sc, const float* sh, bf16* hrow) {
    const float rs = rsqrtf(ssq * (1.f / DM) + 1e-6f);
#pragma unroll
    for (int j = 0; j < 4; ++j) { const int c = 4 * C.lane + 256 * j; const f4 gg = *(const f4*)(g + c), s1 = *(const f4*)(sc + c), s0 = *(const f4*)(sh + c);
        const f4 y = x[j] * rs * gg * (1.f + s1) + s0;
        *(GAS unsigned long long*)(hrow + c) = (unsigned long long)pk2(y.x, y.y) | ((unsigned long long)pk2(y.z, y.w) << 32); }
}
__device__ __forceinline__ void phase_norm_in(const Ctx& C) {
    const int gw = C.wg * NWAVES + C.wave, NGW = C.G * NWAVES;
    const float* ng = INP(I_NORMG);
    for (int m = gw; m < MT; m += NGW) {
        const float* xr = m < MC ? INP(I_XP) + (size_t)m * DM : INP(I_XS) + (size_t)(m - MC) * DM;
        float* xo = C.out + O_X + (size_t)m * DM;
        f4 x[4]; float ss = 0.f;
#pragma unroll
        for (int j = 0; j < 4; ++j) { x[j] = *(const f4*)(xr + 4 * C.lane + 256 * j); *(f4*)(xo + 4 * C.lane + 256 * j) = x[j]; ss += (x[j].x * x[j].x + x[j].y * x[j].y) + (x[j].z * x[j].z + x[j].w * x[j].w); }
        ss = wave_sum(ss);
        const float* md = mod_row(C, 0, m);
        write_h(C, x, ss, ng + 0 * DM, md + 1 * DM, md + 0 * DM, WSP(bf16, WS_H) + (size_t)m * DM);
    }
}
__device__ __forceinline__ void phase_norm_res(const Ctx& C, int l, int which) {
    const int gw = C.wg * NWAVES + C.wave, NGW = C.G * NWAVES;
    const float* ng = INP(I_NORMG);
    const float* gpost = ng + ((size_t)l * 4 + (which ? 3 : 1)) * DM;
    const bool wh = which == 0 || l + 1 < DEPTH;
    const int ln = which ? l + 1 : l;
    const float* gpre = ng + ((size_t)ln * 4 + (which ? 0 : 2)) * DM;
    const float* GO = WSP(const float, WS_GO);
    for (int m = gw; m < MT; m += NGW) {
        const float* gr = GO + (size_t)m * DM; float* xo = C.out + O_X + (size_t)m * DM;
        const float* md = mod_row(C, l, m);
        const float* gate = md + (which ? 5 : 2) * DM;
        f4 go[4], x[4]; float ss = 0.f;
#pragma unroll
        for (int j = 0; j < 4; ++j) { go[j] = *(const f4*)(gr + 4 * C.lane + 256 * j); x[j] = *(const f4*)(xo + 4 * C.lane + 256 * j); ss += (go[j].x * go[j].x + go[j].y * go[j].y) + (go[j].z * go[j].z + go[j].w * go[j].w); }
        ss = wave_sum(ss);
        const float rs = rsqrtf(ss * (1.f / DM) + 1e-6f); float s2 = 0.f;
#pragma unroll
        for (int j = 0; j < 4; ++j) { const int c = 4 * C.lane + 256 * j; const f4 gp = *(const f4*)(gpost + c), gt = *(const f4*)(gate + c);
            x[j] = x[j] + gt * (go[j] * rs * gp); *(f4*)(xo + c) = x[j]; s2 += (x[j].x * x[j].x + x[j].y * x[j].y) + (x[j].z * x[j].z + x[j].w * x[j].w); }
        if (wh) {
            s2 = wave_sum(s2);
            const float* md2 = mod_row(C, ln, m);
            write_h(C, x, s2, gpre, md2 + (which ? 1 : 4) * DM, md2 + (which ? 0 : 3) * DM, WSP(bf16, WS_H) + (size_t)m * DM);
        }
    }
}

typedef unsigned v2u __attribute__((ext_vector_type(2)));
#define WAVE_LDS_SYNC() do { asm volatile("s_waitcnt lgkmcnt(0)" ::: "memory"); } while (0)
__device__ __forceinline__ v2u ld8(const bf16* p) { return *(const GAS v2u*)p; }
__device__ __forceinline__ v4u ld16(const bf16* p) { return *(const GAS v4u*)p; }
__device__ __forceinline__ void st16bf(bf16* p, const float (&v)[16]) {
    v4u a, b; a.x = pk2(v[0], v[1]); a.y = pk2(v[2], v[3]); a.z = pk2(v[4], v[5]); a.w = pk2(v[6], v[7]); b.x = pk2(v[8], v[9]); b.y = pk2(v[10], v[11]); b.z = pk2(v[12], v[13]); b.w = pk2(v[14], v[15]);
    *(GAS v4u*)p = a; *(GAS v4u*)(p + 8) = b;
}
__device__ __forceinline__ float rw_mix(const bf16* PROJ, gcf mu, bool lat, int T, int m, int t, int col) {
    const float p = bf2f(PROJ[(size_t)m * PINP + col]);
    bool ok; int src;
    if (!lat) { const bool fw = col >= 432; ok = fw ? (t <= T - 2) : (t >= 1); src = fw ? m + 1 : m - 1; }
    else { const int gc = t & 63, gr = t >> 6; const int qd = col < 216 ? 0 : (col < 432 ? 1 : (col < 648 ? 2 : 3));
        ok = qd == 0 ? gc > 0 : (qd == 1 ? gc < 63 : (qd == 2 ? gr > 0 : gr < 15)); src = qd == 0 ? m - 1 : (qd == 1 ? m + 1 : (qd == 2 ? m - 64 : m + 64)); }
    src = ok ? src : m;
    const float s = ok ? bf2f(PROJ[(size_t)src * PINP + col]) : 0.f;
    return p + (s - p) * mu[col];
}
__device__ __forceinline__ float ldsbf(const LAS unsigned char* p) { return bf2f(*(const LAS bf16*)p); }
__device__ __forceinline__ void stsbf(LAS unsigned char* p, float v) { *(LAS bf16*)p = (bf16)f2bf(v); }
__device__ __forceinline__ void rw_src(bool lat, int T, int m, int t, int col, bool& ok, int& src) {
    if (!lat) { const bool fw = col >= 432; ok = fw ? (t <= T - 2) : (t >= 1); src = fw ? m + 1 : m - 1; }
    else { const int gc = t & 63, gr = t >> 6; const int qd = col < 216 ? 0 : (col < 432 ? 1 : (col < 648 ? 2 : 3));
        ok = qd == 0 ? gc > 0 : (qd == 1 ? gc < 63 : (qd == 2 ? gr > 0 : gr < 15)); src = qd == 0 ? m - 1 : (qd == 1 ? m + 1 : (qd == 2 ? m - 64 : m + 64)); }
    src = ok ? src : m;
}
__device__ __forceinline__ void prep_rw_all(const Ctx& C, int l, int gw, int NGW) {
    const int lane = C.lane, h = gw & 3;
    int c = h * 64 + lane; asm volatile("" : "+v"(c));
    LAS unsigned char* wl = C.lds + C.wave * 16384;
    constexpr int RAW = 0, EXT = 6144, EXS = 7680, MXO = 9216, MUO = 14336;
    LAS float* MX = (LAS float*)(wl + MXO); LAS float* MU = (LAS float*)(wl + MUO);
    const bf16* PROJ = WSP(const bf16, WS_PROJ); gcf mu = INP(I_RWMU) + l * RWC;
    float w2r[2][16], a2r[2][16];
#pragma unroll
    for (int d = 0; d < 2; ++d)
#pragma unroll
        for (int jj = 0; jj < 16; ++jj) { w2r[d][jj] = INP(I_RWW2)[(((size_t)l * 2 + d) * 16 + jj) * 256 + c]; a2r[d][jj] = INP(I_RWA2)[(((size_t)l * 2 + d) * 16 + jj) * 256 + c]; }
    const float w0_0 = INP(I_RWW0)[(l * 2 + 0) * 256 + c], w0_1 = INP(I_RWW0)[(l * 2 + 1) * 256 + c];
    const float a0_0 = INP(I_RWA0)[(l * 2 + 0) * 256 + c], a0_1 = INP(I_RWA0)[(l * 2 + 1) * 256 + c];
    const float kkw = INP(I_RWKK)[l * 256 + c], ka = INP(I_RWKA)[l * 256 + c], rk = INP(I_RWRK)[l * 256 + c];
    const float mu_r = mu[c], mu_k = mu[256 + c], mu_v = mu[512 + c];
    MU[lane] = mu[768 + lane]; if (lane < 32) MU[64 + lane] = mu[832 + lane];
    bf16* const oarr[9] = {WSP(bf16, WS_RW_R), WSP(bf16, WS_RW_KK), WSP(bf16, WS_RW_V), WSP(bf16, WS_RW_KD), WSP(bf16, WS_RW_KD) + (size_t)MT * 256, WSP(bf16, WS_RW_B), WSP(bf16, WS_RW_B) + (size_t)MT * 256,
                           WSP(bf16, WS_RW_E), WSP(bf16, WS_RW_E) + (size_t)MT * 256};
    float* oBON = WSP(float, WS_RW_BON);
#pragma unroll 1
    for (int tile = gw >> 2; tile < MT / 8; tile += NGW >> 2) {
        const int m0 = tile * 8; const bool lat = m0 >= MC; const int T = lat ? TL : TC; const int ms = lat ? MC + (((m0 - MC) >> 10) << 10) : (m0 & ~255); const int t0 = m0 - ms;
        {
            const int j = lane >> 3, part = lane & 7; v4u own[3], sh[3];
#pragma unroll
            for (int a = 0; a < 3; ++a) { const int col0 = a * 256 + h * 64 + part * 8; bool ok; int src; rw_src(lat, T, m0 + j, t0 + j, col0, ok, src);
                own[a] = ld16(PROJ + (size_t)(m0 + j) * PINP + col0); sh[a] = ld16(PROJ + (size_t)src * PINP + col0); if (!ok) sh[a] = (v4u){0u, 0u, 0u, 0u}; }
            v4u eo[2], es[2];
#pragma unroll
            for (int i = 0; i < 2; ++i) { const int p = lane + 64 * i; const int pj = p < 96 ? p / 12 : 0, ch = p < 96 ? p % 12 : 0; const int col0 = 768 + ch * 8; bool ok; int src; rw_src(lat, T, m0 + pj, t0 + pj, col0, ok, src);
                eo[i] = ld16(PROJ + (size_t)(m0 + pj) * PINP + col0); es[i] = ld16(PROJ + (size_t)src * PINP + col0); if (!ok) es[i] = (v4u){0u, 0u, 0u, 0u}; }
#pragma unroll
            for (int a = 0; a < 3; ++a) { *(LAS v4u*)(wl + RAW + a * 1024 + j * 128 + part * 16) = own[a]; *(LAS v4u*)(wl + RAW + (3 + a) * 1024 + j * 128 + part * 16) = sh[a]; }
#pragma unroll
            for (int i = 0; i < 2; ++i) { const int p = lane + 64 * i; if (p < 96) { const int pj = p / 12, ch = p % 12; *(LAS v4u*)(wl + EXT + pj * 192 + ch * 16) = eo[i]; *(LAS v4u*)(wl + EXS + pj * 192 + ch * 16) = es[i]; } }
        }
        WAVE_LDS_SYNC();
#pragma unroll
        for (int i = 0; i < 12; ++i) { const int idx = lane + 64 * i, j = idx / 96, e = idx - j * 96;
            const float o = ldsbf(wl + EXT + j * 192 + e * 2), s = ldsbf(wl + EXS + j * 192 + e * 2); float v = o + (s - o) * MU[e];
            v = e < 32 ? tanhf(v) : (e < 64 ? v : sigmoidf_(v)); MX[idx] = v; }
        WAVE_LDS_SYNC();
#pragma unroll 1
        for (int half = 0; half < 2; ++half) {
#pragma unroll 1
            for (int jj = 0; jj < 4; ++jj) {
                const int j = half * 4 + jj;
                float r = ldsbf(wl + RAW + 0 * 1024 + j * 128 + lane * 2), k = ldsbf(wl + RAW + 1 * 1024 + j * 128 + lane * 2), v = ldsbf(wl + RAW + 2 * 1024 + j * 128 + lane * 2);
                r += (ldsbf(wl + RAW + 3 * 1024 + j * 128 + lane * 2) - r) * mu_r; k += (ldsbf(wl + RAW + 4 * 1024 + j * 128 + lane * 2) - k) * mu_k; v += (ldsbf(wl + RAW + 5 * 1024 + j * 128 + lane * 2) - v) * mu_v;
                const float kkr = k * kkw; const float ssq = wave_sum(kkr * kkr); const float kkn = kkr / fmaxf(sqrtf(ssq), 1e-12f);
                float lw0 = 0.f, lw1 = 0.f, la0 = 0.f, la1 = 0.f;
#pragma unroll
                for (int q = 0; q < 16; ++q) { lw0 += MX[j * 96 + q] * w2r[0][q]; lw1 += MX[j * 96 + 16 + q] * w2r[1][q]; la0 += MX[j * 96 + 32 + q] * a2r[0][q]; la1 += MX[j * 96 + 48 + q] * a2r[1][q]; }
                const float e0 = 0.6065306597126334f * sigmoidf_(w0_0 + lw0), e1 = 0.6065306597126334f * sigmoidf_(w0_1 + lw1);
                const float a0 = sigmoidf_(a0_0 + la0), a1 = sigmoidf_(a0_1 + la1);
                const float kd0 = k * (1.f + (a0 - 1.f) * ka), kd1 = k * (1.f + (a1 - 1.f) * ka);
                const float bon = wave_sum(r * (kd0 + kd1) * rk);
                if (lane == 0) oBON[(size_t)(m0 + j) * 4 + h] = bon;
                const float ov[9] = {r, kkn, v, kd0, kd1, kkn * a0, kkn * a1, e0, e1};
#pragma unroll
                for (int a = 0; a < 9; ++a) stsbf(wl + (a < 6 ? EXT + a * 512 : 12288 + (a - 6) * 512) + jj * 128 + lane * 2, ov[a]);
            }
            WAVE_LDS_SYNC();
            if (lane < 32) { const int jj = lane >> 3, part = lane & 7; const size_t go = (size_t)(m0 + half * 4 + jj) * 256 + h * 64 + part * 8;
#pragma unroll
                for (int a = 0; a < 9; ++a) *(GAS v4u*)(oarr[a] + go) = *(const LAS v4u*)(wl + (a < 6 ? EXT + a * 512 : 12288 + (a - 6) * 512) + jj * 128 + part * 16); }
            WAVE_LDS_SYNC();
        }
    }
}
__device__ __forceinline__ void prep_rwg_all(const Ctx& C, int l, int gw, int NGW) {
    const int lane = C.lane, h = gw & 3;
    int c = h * 64 + lane; asm volatile("" : "+v"(c));
    LAS unsigned char* wl = C.lds + C.wave * 16384;
    LAS float* SGm = (LAS float*)(wl + 2048);
    const bf16* PROJ = WSP(const bf16, WS_PROJ); gcf mu = INP(I_RWMU) + l * RWC;
    float g2r[32];
#pragma unroll
    for (int jj = 0; jj < 32; ++jj) g2r[jj] = INP(I_RWG2)[((size_t)l * 32 + jj) * 256 + c];
    const float mug = mu[C_RW_GD + (lane & 31)];
    bf16* oG = WSP(bf16, WS_RW_G);
#pragma unroll 1
    for (int tile = gw >> 2; tile < MT / 8; tile += NGW >> 2) {
        const int m0 = tile * 8; const bool lat = m0 >= MC; const int T = lat ? TL : TC; const int ms = lat ? MC + (((m0 - MC) >> 10) << 10) : (m0 & ~255); const int t0 = m0 - ms;
        if (lane < 32) { const int j = lane >> 2, ch = lane & 3, col0 = C_RW_GD + ch * 8; bool ok; int src; rw_src(lat, T, m0 + j, t0 + j, col0, ok, src);
            v4u o = ld16(PROJ + (size_t)(m0 + j) * PINP + col0), s = ld16(PROJ + (size_t)src * PINP + col0); if (!ok) s = (v4u){0u, 0u, 0u, 0u};
            *(LAS v4u*)(wl + j * 64 + ch * 16) = o; *(LAS v4u*)(wl + 512 + j * 64 + ch * 16) = s; }
        WAVE_LDS_SYNC();
#pragma unroll
        for (int i = 0; i < 4; ++i) { const int idx = lane + 64 * i, j = idx >> 5, e = idx & 31; const float o = ldsbf(wl + j * 64 + e * 2), s = ldsbf(wl + 512 + j * 64 + e * 2); SGm[idx] = sigmoidf_(o + (s - o) * mug); }
        WAVE_LDS_SYNC();
#pragma unroll 1
        for (int j = 0; j < 8; ++j) { float g = 0.f;
#pragma unroll
            for (int q = 0; q < 32; ++q) g += SGm[j * 32 + q] * g2r[q];
            stsbf(wl + 4096 + j * 128 + lane * 2, g); }
        WAVE_LDS_SYNC();
        { const int j = lane >> 3, part = lane & 7; *(GAS v4u*)(oG + (size_t)(m0 + j) * 256 + h * 64 + part * 8) = *(const LAS v4u*)(wl + 4096 + j * 128 + part * 16); }
        WAVE_LDS_SYNC();
    }
}
__device__ __forceinline__ void prep_hg(const Ctx& C, int l, int job) {
    const int lane = C.lane, h = job & 3, d = (job >> 2) & 1, blk = job >> 3, m0 = blk * 16, c = h * 64 + lane;
    LAS unsigned char* wl = C.lds + C.wave * 16384;
    const int row = lane >> 3, part = lane & 7;
    {
        const bf16* P0 = WSP(const bf16, WS_PROJ) + (size_t)(m0 + row) * PINP + h * 64 + part * 8;
        const v4u q0 = ld16(P0 + C_HG_Q), q1 = ld16(P0 + 8 * PINP + C_HG_Q), f0 = ld16(P0 + C_HG_F + d * 256), f1 = ld16(P0 + 8 * PINP + C_HG_F + d * 256);
        v4u i0 = (v4u){0u, 0u, 0u, 0u}, i1 = i0; if (d == 0) { i0 = ld16(P0 + C_HG_I); i1 = ld16(P0 + 8 * PINP + C_HG_I); }
        *(LAS v4u*)(wl + row * 128 + part * 16) = q0; *(LAS v4u*)(wl + 1024 + row * 128 + part * 16) = q1;
        *(LAS v4u*)(wl + 2048 + row * 128 + part * 16) = f0; *(LAS v4u*)(wl + 3072 + row * 128 + part * 16) = f1;
        *(LAS v4u*)(wl + 4096 + row * 128 + part * 16) = i0; *(LAS v4u*)(wl + 5120 + row * 128 + part * 16) = i1;
    }
    WAVE_LDS_SYNC();
    float q[16], fr[16];
#pragma unroll
    for (int j = 0; j < 16; ++j) { q[j] = ldsbf(wl + j * 128 + lane * 2); fr[j] = ldsbf(wl + 2048 + j * 128 + lane * 2); }
    if (d == 0) { float iv[16];
#pragma unroll
        for (int j = 0; j < 16; ++j) iv[j] = ldsbf(wl + 4096 + j * 128 + lane * 2);
        st16bf(WSP(bf16, WS_HG_VT) + ((size_t)blk * 256 + c) * 16, iv); }
    const float lb = WSP(const float, WS_LB)[(l * 2 + d) * 256 + c], omlb = 1.f - lb;
    float kd[16], lf[16], cin[16];
#pragma unroll
    for (int j = 0; j < 16; ++j) { const float sg = sigmoidf_(fr[j]); kd[j] = omlb * (1.f - sg); lf[j] = __logf(fmaxf(lb + omlb * sg, 1e-30f)); }
    float run = 0.f;
#pragma unroll
    for (int jj = 0; jj < 16; ++jj) { const int j = d ? 15 - jj : jj; run += lf[j]; cin[j] = run; }
    const float tot = run;
    float kt[16];
#pragma unroll
    for (int j = 0; j < 16; ++j) { stsbf(wl + 6144 + j * 128 + lane * 2, siluf_(q[j]) * __expf(cin[j])); stsbf(wl + 8192 + j * 128 + lane * 2, kd[j] * __expf(fminf(-cin[j], 60.f))); kt[j] = kd[j] * __expf(tot - cin[j]); }
    st16bf(WSP(bf16, WS_HG_KT) + (((size_t)d * NBLK + blk) * 256 + c) * 16, kt);
    WSP(float, WS_HG_G)[((size_t)d * NBLK + blk) * 256 + c] = __expf(tot);
    WAVE_LDS_SYNC();
    {
        bf16* oQT = WSP(bf16, WS_HG_QT) + ((size_t)d * MT + m0 + row) * 256 + h * 64 + part * 8; bf16* oKD = WSP(bf16, WS_HG_KD) + ((size_t)d * MT + m0 + row) * 256 + h * 64 + part * 8;
        *(GAS v4u*)oQT = *(const LAS v4u*)(wl + 6144 + row * 128 + part * 16); *(GAS v4u*)(oQT + 8 * 256) = *(const LAS v4u*)(wl + 7168 + row * 128 + part * 16);
        *(GAS v4u*)oKD = *(const LAS v4u*)(wl + 8192 + row * 128 + part * 16); *(GAS v4u*)(oKD + 8 * 256) = *(const LAS v4u*)(wl + 9216 + row * 128 + part * 16);
    }
    WAVE_LDS_SYNC();
}
__device__ __forceinline__ void conv16_lds(const bf16* colbase  , int t0, int T, LAS unsigned char* dst, int lane, const float (&w)[4], float bias, float (&y)[16]) {
    v4u v[3];
#pragma unroll
    for (int i = 0; i < 3; ++i) { const int p = lane + 64 * i, row = p >> 3, part = p & 7, t = t0 - 2 + row; const bool ok = p < 152 && t >= 0 && t < T;
        v[i] = ld16(colbase + (size_t)(ok ? t : t0) * PINP + part * 8); if (!ok) v[i] = (v4u){0u, 0u, 0u, 0u}; }
#pragma unroll
    for (int i = 0; i < 3; ++i) { const int p = lane + 64 * i; if (p < 152) *(LAS v4u*)(dst + (p >> 3) * 128 + (p & 7) * 16) = v[i]; }
    WAVE_LDS_SYNC();
    float x[19];
#pragma unroll
    for (int i = 0; i < 19; ++i) x[i] = ldsbf(dst + i * 128 + lane * 2);
#pragma unroll
    for (int j = 0; j < 16; ++j) y[j] = bias + w[0] * x[j] + w[1] * x[j + 1] + w[2] * x[j + 2] + w[3] * x[j + 3];
}
__device__ __forceinline__ void prep_ss(const Ctx& C, int l, int job) {
    const int lane = C.lane, grp = job % 12, blk = job / 12, kind = grp >> 2, sub = grp & 3, m0 = blk * 16, cc = sub * 64 + lane, c = kind * 256 + cc;
    const bool lat = m0 >= MC; const int T = lat ? TL : TC; const int ms = lat ? MC + (((m0 - MC) >> 10) << 10) : (m0 & ~255); const int t0 = m0 - ms;
    const bf16* PROJ = WSP(const bf16, WS_PROJ);
    LAS unsigned char* wl = C.lds + C.wave * 16384;
    float w[4], y[16];
#pragma unroll
    for (int j = 0; j < 4; ++j) w[j] = INP(I_SSCW)[((size_t)l * 4 + j) * 768 + c];
    conv16_lds(PROJ + (size_t)ms * PINP + C_SS_XBC + kind * 256 + sub * 64, t0, T, wl, lane, w, INP(I_SSCB)[l * 768 + c], y);
#pragma unroll
    for (int j = 0; j < 16; ++j) y[j] = siluf_(y[j]);
    if (kind != 0) {
#pragma unroll
        for (int j = 0; j < 16; ++j) stsbf(wl + 4096 + j * 128 + lane * 2, y[j]);
        if (kind == 1) st16bf(WSP(bf16, WS_SS_BT) + ((size_t)blk * 256 + cc) * 16, y);
        WAVE_LDS_SYNC();
        const int row = lane >> 3, part = lane & 7;
        bf16* o = (kind == 1 ? WSP(bf16, WS_SS_B) : WSP(bf16, WS_SS_C)) + (size_t)(m0 + row) * 256 + sub * 64 + part * 8;
        *(GAS v4u*)o = *(const LAS v4u*)(wl + 4096 + row * 128 + part * 16); *(GAS v4u*)(o + 8 * 256) = *(const LAS v4u*)(wl + 5120 + row * 128 + part * 16);
    } else {
        const int h = sub;
        LAS float* DTs = (LAS float*)(wl + 8192);
        if (lane < 32) { const int dd = lane >> 4, j = lane & 15;
            const float dtr = bf2f(PROJ[(size_t)(m0 + j) * PINP + C_SS_DT + dd * 4 + h]);
            const float dt = softplusf_(dtr + INP(I_SSDTB)[(l * 2 + dd) * 4 + h]);
            DTs[lane] = dt; DTs[32 + lane] = dt * (-__expf(INP(I_SSALOG)[(l * 2 + dd) * 4 + h])); }
        WAVE_LDS_SYNC();
#pragma unroll
        for (int dd = 0; dd < 2; ++dd) {
            float dt[16], cin[16], run = 0.f;
#pragma unroll
            for (int j = 0; j < 16; ++j) dt[j] = DTs[dd * 16 + j];
#pragma unroll
            for (int jj = 0; jj < 16; ++jj) { const int j = dd ? 15 - jj : jj; run += DTs[32 + dd * 16 + j]; cin[j] = run; }
            const float tot = run;
            float xt[16], xw[16];
#pragma unroll
            for (int j = 0; j < 16; ++j) { xt[j] = y[j] * dt[j]; xw[j] = xt[j] * __expf(tot - cin[j]); }
            st16bf(WSP(bf16, WS_SS_XT) + (((size_t)dd * NBLK + blk) * 256 + cc) * 16, xt);
            st16bf(WSP(bf16, WS_SS_XWT) + (((size_t)dd * NBLK + blk) * 256 + cc) * 16, xw);
            if (lane == dd) {
                float* oc = WSP(float, WS_SS_CIN) + (((size_t)dd * NBLK + blk) * 4 + h) * 16;
#pragma unroll
                for (int j = 0; j < 16; j += 4) *(GAS f4*)(oc + j) = (f4){cin[j], cin[j + 1], cin[j + 2], cin[j + 3]};
                WSP(float, WS_SS_G)[((size_t)dd * NBLK + blk) * 4 + h] = __expf(tot);
                if (dd == 0) { float* od = WSP(float, WS_SS_DT) + ((size_t)blk * 4 + h) * 16;
#pragma unroll
                    for (int j = 0; j < 16; j += 4) *(GAS f4*)(od + j) = (f4){dt[j], dt[j + 1], dt[j + 2], dt[j + 3]}; }
            }
        }
    }
    WAVE_LDS_SYNC();
}
__device__ __forceinline__ void prep_lr_all(const Ctx& C, int l, int gw, int NGW) {
    const int lane = C.lane, h = gw & 3, d = (gw >> 2) & 1, c = h * 64 + lane, fr = lane & 15, fq = lane >> 4;
    LAS unsigned char* wl = C.lds + C.wave * 16384;
    LAS float* XCf = (LAS float*)(wl + 4096);
    LAS bf16* XCb = (LAS bf16*)(wl + 8192);
    LAS float* LAQ = (LAS float*)(wl + 10496);
    const bf16* PROJ = WSP(const bf16, WS_PROJ);
    bf16x8 Bw[2][2][4];
    const bf16* WLR = WSP(const bf16, WS_WLR);
#pragma unroll
    for (int ks = 0; ks < 2; ++ks)
#pragma unroll
        for (int g = 0; g < 2; ++g)
#pragma unroll
            for (int nt = 0; nt < 4; ++nt) Bw[ks][g][nt] = *(const GAS bf16x8*)(WLR + ((((size_t)(l * 2 + d) * 2 + g) * 4 + h) * 64 + nt * 16 + fr) * 64 + ks * 32 + 8 * fq);
    float bav[4], bxv[4], spv[4];
#pragma unroll
    for (int nt = 0; nt < 4; ++nt) { const int cg = h * 64 + nt * 16 + fr; bav[nt] = INP(I_LRBA)[(l * 2 + d) * 256 + cg]; bxv[nt] = INP(I_LRBX)[(l * 2 + d) * 256 + cg]; spv[nt] = softplusf_(-INP(I_LRLAM)[(l * 2 + d) * 256 + cg]); }
    float w[4];
#pragma unroll
    for (int j = 0; j < 4; ++j) w[j] = INP(I_LRCW)[((size_t)l * 4 + j) * 256 + c];
    const float cbias = INP(I_LRCB)[l * 256 + c];
#pragma unroll 1
    for (int blk = gw >> 3; blk < NBLK; blk += NGW >> 3) {
        const int m0 = blk * 16; const bool lat = m0 >= MC; const int T = lat ? TL : TC; const int ms = lat ? MC + (((m0 - MC) >> 10) << 10) : (m0 & ~255); const int t0 = m0 - ms;
        {
            float y[16];
            conv16_lds(PROJ + (size_t)ms * PINP + C_LR_X + h * 64, t0, T, wl, lane, w, cbias, y);
#pragma unroll
            for (int j = 0; j < 16; ++j) { XCf[j * 64 + lane] = y[j]; XCb[j * 72 + lane] = (bf16)f2bf(y[j]); }
        }
        WAVE_LDS_SYNC();
        {
            f32x4 acc[2][4];
#pragma unroll
            for (int g = 0; g < 2; ++g)
#pragma unroll
                for (int nt = 0; nt < 4; ++nt) acc[g][nt] = (f32x4){0.f, 0.f, 0.f, 0.f};
#pragma unroll
            for (int ks = 0; ks < 2; ++ks) {
                const bf16x8 A = *(const LAS bf16x8*)(XCb + fr * 72 + ks * 32 + 8 * fq);
#pragma unroll
                for (int g = 0; g < 2; ++g)
#pragma unroll
                    for (int nt = 0; nt < 4; ++nt) acc[g][nt] = __builtin_amdgcn_mfma_f32_16x16x32_bf16(A, Bw[ks][g][nt], acc[g][nt], 0, 0, 0);
            }
#pragma unroll
            for (int nt = 0; nt < 4; ++nt) {
                const int ch = nt * 16 + fr;
#pragma unroll
                for (int rg = 0; rg < 4; ++rg) {
                    const int j = fq * 4 + rg;
                    const float r = sigmoidf_(acc[0][nt][rg] + bav[nt]), ig = sigmoidf_(acc[1][nt][rg] + bxv[nt]);
                    const float la = -8.f * r * spv[nt];
                    LAQ[j * 64 + ch] = la; XCf[j * 64 + ch] = sqrtf(fmaxf(-expm1f(2.f * la), 0.f)) * (ig * XCf[j * 64 + ch]);
                }
            }
        }
        WAVE_LDS_SYNC();
        {
            float A = 1.f, H = 0.f;
#pragma unroll
            for (int jj = 0; jj < 16; ++jj) { const int j = d ? 15 - jj : jj; const float a = __expf(LAQ[j * 64 + lane]); A *= a; H = a * H + XCf[j * 64 + lane];
                stsbf(wl + j * 128 + lane * 2, A); stsbf(wl + 2048 + j * 128 + lane * 2, H); }
            WSP(float, WS_LR_AE)[((size_t)d * NBLK + blk) * 256 + c] = A; WSP(float, WS_LR_HE)[((size_t)d * NBLK + blk) * 256 + c] = H;
        }
        WAVE_LDS_SYNC();
        {
            const int row = lane >> 3, part = lane & 7;
            bf16* oAL = WSP(bf16, WS_LR_AL) + ((size_t)d * MT + m0 + row) * 256 + h * 64 + part * 8; bf16* oHL = WSP(bf16, WS_LR_HL) + ((size_t)d * MT + m0 + row) * 256 + h * 64 + part * 8;
            *(GAS v4u*)oAL = *(const LAS v4u*)(wl + row * 128 + part * 16); *(GAS v4u*)(oAL + 8 * 256) = *(const LAS v4u*)(wl + 1024 + row * 128 + part * 16);
            *(GAS v4u*)oHL = *(const LAS v4u*)(wl + 2048 + row * 128 + part * 16); *(GAS v4u*)(oHL + 8 * 256) = *(const LAS v4u*)(wl + 3072 + row * 128 + part * 16);
        }
        WAVE_LDS_SYNC();
    }
}
__device__ __forceinline__ void phase_prep(const Ctx& C, int l) {
    const int gw = C.wg * NWAVES + C.wave, NGW = C.G * NWAVES;
#ifndef PREPEN
#define PREPEN 15
#endif
    for (int rep = 0; rep < NREP(8); ++rep) if (PREPEN & 1) { prep_rw_all(C, l, gw, NGW); prep_rwg_all(C, l, gw, NGW); }
    for (int rep = 0; rep < NREP(9); ++rep) if (PREPEN & 2) {
#pragma unroll 1
    for (int j = gw; j < NBLK * 12; j += NGW) prep_ss(C, l, j); }
    for (int rep = 0; rep < NREP(10); ++rep) if (PREPEN & 4) prep_lr_all(C, l, gw, NGW);
    for (int rep = 0; rep < NREP(11); ++rep) if (PREPEN & 8) {
#pragma unroll 1
    for (int j = gw; j < NBLK * 8; j += NGW) prep_hg(C, l, j); }
}

constexpr int SC_Y = 49152;
#define STEP_TOKEN(cc, s) (d ? (T - 1 - ((cc) * 32 + (s))) : ((cc) * 32 + (s)))
__device__ __forceinline__ void flush_y(const Ctx& C, bf16* ydst, int cc, int d, int T) {
    const LAS float* Y = (const LAS float*)(C.lds + SC_Y);
    const int s = C.tid >> 4, pr = C.tid & 15; const int t = STEP_TOKEN(cc, s);
    *(GAS unsigned*)(ydst + (size_t)t * 256 + 2 * pr) = pk2(Y[s * 32 + 2 * pr], Y[s * 32 + 2 * pr + 1]);
}
__device__ __forceinline__ void scan_rwkv(const Ctx& C, int l, int lat, int b, int d, int h, int rb) {
    const int tid = C.tid, row = tid >> 4, q = tid & 15;
    const int T = lat ? TL : TC, ms = lat ? MC + b * TL : b * TC, nch = T / 32;
    LAS float* LW = (LAS float*)C.lds; LAS float* LKK = LW + 2048; LAS float* LB_ = LW + 4096; LAS float* LKD = LW + 6144; LAS float* LR = LW + 8192; LAS float* LV = LW + 10240; LAS float* LY = (LAS float*)(C.lds + SC_Y);
    const int hi = tid >> 8, p = tid & 255, ps = p >> 3, pp = p & 7;
    const size_t doff = (size_t)d * MT * 256;
    const bf16* a0 = (hi ? WSP(const bf16, WS_RW_KK) : WSP(const bf16, WS_RW_E) + doff) + (size_t)ms * 256 + h * 64 + pp * 8;
    const bf16* a1 = (hi ? WSP(const bf16, WS_RW_KD) + doff : WSP(const bf16, WS_RW_B) + doff) + (size_t)ms * 256 + h * 64 + pp * 8;
    const bf16* a2 = hi ? WSP(const bf16, WS_RW_V) + (size_t)ms * 256 + h * 64 + rb * 32 + (p & 3) * 8 : WSP(const bf16, WS_RW_R) + (size_t)ms * 256 + h * 64 + pp * 8;
    const int s2 = hi ? (p >> 2) : ps; const bool do2 = !hi || p < 128;
    LAS float* d0 = (hi ? LKK : LW) + ps * 64 + pp * 8; LAS float* d1 = (hi ? LKD : LB_) + ps * 64 + pp * 8; LAS float* d2 = hi ? LV + (p >> 2) * 32 + (p & 3) * 8 : LR + ps * 64 + pp * 8;
    f2 Sa, Sb;
    const int v = rb * 32 + row;
    if (lat) { const f4 s = *(const GAS f4*)(INP(I_SRW) + ((((size_t)(b * 4 + l) * 2 + d) * 4 + h) * 64 + v) * 64 + 4 * q); Sa = s.xy; Sb = s.zw; }
    else { Sa = (f2){0.f, 0.f}; Sb = Sa; }
    bf16* ydst = WSP(bf16, WS_YS) + ((size_t)d * MT + ms) * 256 + h * 64 + rb * 32;
    v4u pf0, pf1, pf2 = (v4u){0u, 0u, 0u, 0u};
    { pf0 = ld16(a0 + (size_t)STEP_TOKEN(0, ps) * 256); pf1 = ld16(a1 + (size_t)STEP_TOKEN(0, ps) * 256); if (do2) pf2 = ld16(a2 + (size_t)STEP_TOKEN(0, s2) * 256); }
    const LAS f4* pW = (const LAS f4*)LW + q; const LAS f4* pKK = (const LAS f4*)LKK + q; const LAS f4* pB = (const LAS f4*)LB_ + q; const LAS f4* pKD = (const LAS f4*)LKD + q; const LAS f4* pR = (const LAS f4*)LR + q;
#define RW_LOAD(X, s) const f4 w##X = pW[(s) * 16], kk##X = pKK[(s) * 16], bv##X = pB[(s) * 16], kd##X = pKD[(s) * 16], r##X = pR[(s) * 16]; const float vv##X = LV[(s) * 32 + row];
#define RW_STEP(X, s) { const f2 p2 = Sa * kk##X.xy + Sb * kk##X.zw; const float sa = -sum16(p2.x + p2.y); \
        Sa = Sa * w##X.xy + (sa * bv##X.xy + vv##X * kd##X.xy); Sb = Sb * w##X.zw + (sa * bv##X.zw + vv##X * kd##X.zw); \
        const f2 y2 = Sa * r##X.xy + Sb * r##X.zw; const float yp = sum16(y2.x + y2.y); ykeep = (((s) & 15) == q) ? yp : ykeep; }
#pragma unroll 1
    for (int cc = 0; cc < nch; ++cc) {
        { float o[8]; cvt8(pf0, o); if (!hi) {
#pragma unroll
                for (int i = 0; i < 8; ++i) o[i] = __expf(-o[i]); }
            st8(d0, o); cvt8(pf1, o); st8(d1, o); if (do2) { cvt8(pf2, o); st8(d2, o); } }
        __syncthreads();
        if (cc + 1 < nch) { pf0 = ld16(a0 + (size_t)STEP_TOKEN(cc + 1, ps) * 256); pf1 = ld16(a1 + (size_t)STEP_TOKEN(cc + 1, ps) * 256); if (do2) pf2 = ld16(a2 + (size_t)STEP_TOKEN(cc + 1, s2) * 256); }
        float ykeep = 0.f;
#pragma unroll
        for (int s = 0; s < 32; s += 4) {
            RW_LOAD(A, s) RW_LOAD(B, s + 1)
            RW_STEP(A, s)
            RW_LOAD(C_, s + 2)
            RW_STEP(B, s + 1)
            RW_LOAD(D, s + 3)
            RW_STEP(C_, s + 2)
            RW_STEP(D, s + 3)
            if ((s & 15) == 12) LY[((s & 16) + q) * 32 + row] = ykeep;
        }
        __syncthreads();
        flush_y(C, ydst, cc, d, T);
    }
#undef RW_LOAD
#undef RW_STEP
    if (!lat) *(GAS f4*)(C.out + O_SRW + ((((size_t)(b * 4 + l) * 2 + d) * 4 + h) * 64 + v) * 64 + 4 * q) = (f4){Sa.x, Sa.y, Sb.x, Sb.y};
}

__device__ __forceinline__ bf16x8 mk8(v2u lo, v2u hi) { v4u w; w.x = lo.x; w.y = lo.y; w.z = hi.x; w.w = hi.y; return __builtin_bit_cast(bf16x8, w); }
__device__ __forceinline__ v2u pk4(const f32x4 v) { v2u w; w.x = pk2(v[0], v[1]); w.y = pk2(v[2], v[3]); return w; }
__device__ __forceinline__ v2u pk4h(const f32x4 v) { v2u w; w.x = pg8::cvt_pk_bf16(v[0], v[1]); w.y = pg8::cvt_pk_bf16(v[2], v[3]); return w; }
__device__ __forceinline__ v2u lds8(const LAS unsigned char* p) { return *(const LAS v2u*)p; }
constexpr int HG_ROW = 144;
constexpr int HG_QT = 0, HG_KD = 16 * HG_ROW, HG_KT = 2 * 16 * HG_ROW, HG_VT = HG_KT + 2048, HG_G = HG_VT + 2048, HG_DSZ = HG_G + 256, HG_BUF = 2 * HG_DSZ;
static_assert(HG_DSZ % 16 == 0 && 2 * HG_BUF <= SC_Y, "hg lds");
__device__ __forceinline__ void hg_job(const Ctx& C, int l, int lat, int b, int h) {
    const int tid = C.tid, lane = C.lane, c = lane & 15, g = lane >> 4, d = C.wave >> 2, vt = C.wave & 3;
    const int T = lat ? TL : TC, ms = lat ? MC + b * TL : b * TC, nb = T / 16, blk0 = ms / 16;
    bf16* YO = WSP(bf16, WS_YS) + (size_t)2 * MT * 256 + h * 64 + vt * 16 + c;
    const int ld = tid >> 8, q = tid & 255, qa_ = q & 127;
    const bf16* gA = (q < 128 ? WSP(const bf16, WS_HG_QT) : WSP(const bf16, WS_HG_KD)) + (size_t)ld * MT * 256 + h * 64 + (qa_ >> 3) * 256 + (qa_ & 7) * 8;
    const bf16* gB = q < 128 ? WSP(const bf16, WS_HG_KT) + ((size_t)ld * NBLK * 256 + h * 64) * 16 + qa_ * 8 : WSP(const bf16, WS_HG_VT) + (size_t)(h * 64) * 16 + qa_ * 8;
    const float* gG = WSP(const float, WS_HG_G) + (size_t)ld * NBLK * 256 + h * 64 + (q & 15) * 4;
    const int oA = ld * HG_DSZ + (q < 128 ? HG_QT : HG_KD) + (qa_ >> 3) * HG_ROW + (qa_ & 7) * 16, oB = ld * HG_DSZ + (q < 128 ? HG_KT : HG_VT) + qa_ * 16, oG = ld * HG_DSZ + HG_G + (q & 15) * 16;
    f32x4 st[4];
#pragma unroll
    for (int kt = 0; kt < 4; ++kt) {
        if (lat) { const GAS float* sp = INP(I_SHG) + ((((size_t)(b * 4 + l) * 2 + d) * 4 + h) * 64 + 16 * kt + 4 * g) * 64 + vt * 16 + c; st[kt] = (f32x4){sp[0], sp[64], sp[128], sp[192]}; }
        else st[kt] = (f32x4){0.f, 0.f, 0.f, 0.f};
    }
    v4u rAa, rBa, rAb, rBb; f4 rGa = (f4){0.f, 0.f, 0.f, 0.f}, rGb = rGa;
#define HG_FETCH(X, step) do { const int blk_ = ld ? nb - 1 - (step) : (step); const size_t gb_ = (size_t)blk0 + blk_; rA##X = ld16(gA + gb_ * 16 * 256); rB##X = ld16(gB + gb_ * 4096); if (q < 16) rG##X = *(const GAS f4*)(gG + gb_ * 256); } while (0)
#define HG_PUT(X, buf) do { *(LAS v4u*)((buf) + oA) = rA##X; *(LAS v4u*)((buf) + oB) = rB##X; if (q < 16) *(LAS f4*)((buf) + oG) = rG##X; } while (0)
    auto compute = [&](const int ib, LAS unsigned char* buf) {
        const int blk = d ? nb - 1 - ib : ib; const size_t m0 = (size_t)ms + blk * 16;
        const LAS unsigned char* bd = buf + d * HG_DSZ;
        f32x4 acc = (f32x4){0.f, 0.f, 0.f, 0.f}, sT = (f32x4){0.f, 0.f, 0.f, 0.f};
        unsigned short oo[4];
        const bool rmw = ib >= (nb >> 1);
        if (rmw) {
#pragma unroll
            for (int rg = 0; rg < 4; ++rg) oo[rg] = YO[(m0 + 4 * g + rg) * 256]; }
#pragma unroll
        for (int kap = 0; kap < 2; ++kap) {
            const bf16x8 qa = mk8(lds8(bd + HG_QT + c * HG_ROW + (32 * kap + 4 * g) * 2), lds8(bd + HG_QT + c * HG_ROW + (32 * kap + 16 + 4 * g) * 2));
            const bf16x8 ka = mk8(lds8(bd + HG_KD + c * HG_ROW + (32 * kap + 4 * g) * 2), lds8(bd + HG_KD + c * HG_ROW + (32 * kap + 16 + 4 * g) * 2));
            acc = __builtin_amdgcn_mfma_f32_16x16x32_bf16(qa, mk8(pk4h(st[2 * kap]), pk4h(st[2 * kap + 1])), acc, 0, 0, 0);
            sT = __builtin_amdgcn_mfma_f32_16x16x32_bf16(ka, qa, sT, 0, 0, 0);
        }
#pragma unroll
        for (int rg = 0; rg < 4; ++rg) { const int s = 4 * g + rg; const bool keep = d ? (s >= c) : (s <= c); sT[rg] = keep ? sT[rg] : 0.f; }
        const bf16x8 Bv = mk8(lds8(buf + (d ? HG_DSZ : 0) + HG_VT + (vt * 16 + c) * 32 + 8 * g), (v2u){0u, 0u});
        acc = __builtin_amdgcn_mfma_f32_16x16x32_bf16(mk8(pk4h(sT), (v2u){0u, 0u}), Bv, acc, 0, 0, 0);
#pragma unroll
        for (int rg = 0; rg < 4; ++rg) { float o = acc[rg]; if (rmw) o += bf2f(oo[rg]); YO[(m0 + 4 * g + rg) * 256] = (bf16)f2bf(o); }
#pragma unroll
        for (int kt = 0; kt < 4; ++kt) { const f4 gv = *(const LAS f4*)(bd + HG_G + (16 * kt + 4 * g) * 4); f32x4 s = st[kt]; s[0] *= gv.x; s[1] *= gv.y; s[2] *= gv.z; s[3] *= gv.w;
            st[kt] = __builtin_amdgcn_mfma_f32_16x16x32_bf16(mk8(lds8(bd + HG_KT + (16 * kt + c) * 32 + 8 * g), (v2u){0u, 0u}), Bv, s, 0, 0, 0); }
    };
    HG_FETCH(a, 0); HG_FETCH(b, 1);
#pragma unroll 1
    for (int ib = 0; ib < nb; ib += 2) {
        HG_PUT(a, C.lds); __syncthreads(); if (ib + 2 < nb) HG_FETCH(a, ib + 2); compute(ib, C.lds);
        HG_PUT(b, C.lds + HG_BUF); __syncthreads(); if (ib + 3 < nb) HG_FETCH(b, ib + 3); compute(ib + 1, C.lds + HG_BUF);
    }
#undef HG_FETCH
#undef HG_PUT
    if (!lat) {
#pragma unroll
        for (int kt = 0; kt < 4; ++kt) { GAS float* sp = (GAS float*)(C.out + O_SHG + ((((size_t)(b * 4 + l) * 2 + d) * 4 + h) * 64 + 16 * kt + 4 * g) * 64 + vt * 16 + c); sp[0] = st[kt][0]; sp[64] = st[kt][1]; sp[128] = st[kt][2]; sp[192] = st[kt][3]; }
    }
    __syncthreads();
}
constexpr int SS_ROW = 272;
constexpr int SS_C = 0, SS_B = 16 * SS_ROW, SS_BT = 2 * 16 * SS_ROW, SS_XT = SS_BT + 4096, SS_XW = SS_XT + 2048, SS_CI = SS_XW + 2048, SS_GG = SS_CI + 64, SS_DTV = SS_GG + 16, SS_DSZ = SS_DTV + 64, SS_BUF = 2 * SS_DSZ;
static_assert(SS_DSZ % 16 == 0 && 2 * SS_BUF <= 131072, "ss lds");
__device__ __forceinline__ void ss_job(const Ctx& C, int l, int lat, int b, int h) {
    const int tid = C.tid, lane = C.lane, c = lane & 15, g = lane >> 4, d = C.wave >> 2, pt = C.wave & 3, grp = h >> 1;
    const int T = lat ? TL : TC, ms = lat ? MC + b * TL : b * TC, nb = T / 16, blk0 = ms / 16;
    bf16* YO = WSP(bf16, WS_YS) + (size_t)3 * MT * 256 + h * 64 + pt * 16 + c;
    const float Dh = INP(I_SSD)[l * 4 + h];
    const int ld = tid >> 8, q = tid & 255, qh = q & 127;
    const bf16* gC = WSP(const bf16, WS_SS_C) + grp * 128 + (q >> 4) * 256 + (q & 15) * 8;
    const bf16* gBn = WSP(const bf16, WS_SS_B) + grp * 128 + (q >> 4) * 256 + (q & 15) * 8;
    const bf16* gBT = WSP(const bf16, WS_SS_BT) + (size_t)(grp * 128) * 16 + q * 8;
    const bf16* gX = (q < 128 ? WSP(const bf16, WS_SS_XT) : WSP(const bf16, WS_SS_XWT)) + ((size_t)ld * NBLK * 256 + h * 64) * 16 + qh * 8;
    const float* gS = q < 4 ? WSP(const float, WS_SS_CIN) + ((size_t)ld * NBLK * 4 + h) * 16 + q * 4 : (q < 8 ? WSP(const float, WS_SS_DT) + (size_t)h * 16 + (q - 4) * 4 : WSP(const float, WS_SS_G) + (size_t)ld * NBLK * 4 + h);
    const int oC = ld * SS_DSZ + SS_C + (q >> 4) * SS_ROW + (q & 15) * 16, oBn = ld * SS_DSZ + SS_B + (q >> 4) * SS_ROW + (q & 15) * 16, oBT = ld * SS_DSZ + SS_BT + q * 16,
              oX = ld * SS_DSZ + (q < 128 ? SS_XT : SS_XW) + qh * 16, oS = ld * SS_DSZ + (q < 4 ? SS_CI + q * 16 : (q < 8 ? SS_DTV + (q - 4) * 16 : SS_GG));
    f32x4 st[8];
#pragma unroll
    for (int nt = 0; nt < 8; ++nt) {
        if (lat) st[nt] = *(const GAS f32x4*)(INP(I_SSS) + ((((size_t)(b * 4 + l) * 2 + d) * 4 + h) * 64 + pt * 16 + c) * 128 + 16 * nt + 4 * g);
        else st[nt] = (f32x4){0.f, 0.f, 0.f, 0.f};
    }
    v4u rCa, rBna, rBTa, rXa, rCb, rBnb, rBTb, rXb; f4 rSa = (f4){0.f, 0.f, 0.f, 0.f}, rSb = rSa;
#define SS_FETCH(X, step) do { const int blk_ = ld ? nb - 1 - (step) : (step); const size_t gb_ = (size_t)blk0 + blk_; rC##X = ld16(gC + gb_ * 16 * 256); rBn##X = ld16(gBn + gb_ * 16 * 256); rBT##X = ld16(gBT + gb_ * 4096); rX##X = ld16(gX + gb_ * 4096); \
        if (q < 8) rS##X = *(const GAS f4*)(gS + gb_ * 64); else if (q == 8) rS##X.x = gS[gb_ * 4]; } while (0)
#define SS_PUT(X, buf) do { *(LAS v4u*)((buf) + oC) = rC##X; *(LAS v4u*)((buf) + oBn) = rBn##X; *(LAS v4u*)((buf) + oBT) = rBT##X; *(LAS v4u*)((buf) + oX) = rX##X; \
        if (q < 8) *(LAS f4*)((buf) + oS) = rS##X; else if (q == 8) *(LAS float*)((buf) + oS) = rS##X.x; } while (0)
    auto compute = [&](const int ib, LAS unsigned char* buf) {
        const int blk = d ? nb - 1 - ib : ib; const size_t m0 = (size_t)ms + blk * 16;
        const LAS unsigned char* bd = buf + d * SS_DSZ;
        f32x4 acc = (f32x4){0.f, 0.f, 0.f, 0.f}, sT = (f32x4){0.f, 0.f, 0.f, 0.f};
        unsigned short oo[4];
        const bool rmw = ib >= (nb >> 1);
        if (rmw) {
#pragma unroll
            for (int rg = 0; rg < 4; ++rg) oo[rg] = YO[(m0 + 4 * g + rg) * 256]; }
#pragma unroll
        for (int kap = 0; kap < 4; ++kap) {
            const bf16x8 ca = mk8(lds8(bd + SS_C + c * SS_ROW + (32 * kap + 4 * g) * 2), lds8(bd + SS_C + c * SS_ROW + (32 * kap + 16 + 4 * g) * 2));
            const bf16x8 ba = mk8(lds8(bd + SS_B + c * SS_ROW + (32 * kap + 4 * g) * 2), lds8(bd + SS_B + c * SS_ROW + (32 * kap + 16 + 4 * g) * 2));
            acc = __builtin_amdgcn_mfma_f32_16x16x32_bf16(ca, mk8(pk4h(st[2 * kap]), pk4h(st[2 * kap + 1])), acc, 0, 0, 0);
            sT = __builtin_amdgcn_mfma_f32_16x16x32_bf16(ba, ca, sT, 0, 0, 0);
        }
        const f4 cin4 = *(const LAS f4*)(bd + SS_CI + 16 * g); const float cint = *(const LAS float*)(bd + SS_CI + 4 * c), gg = *(const LAS float*)(bd + SS_GG);
        acc[0] *= __expf(cin4.x); acc[1] *= __expf(cin4.y); acc[2] *= __expf(cin4.z); acc[3] *= __expf(cin4.w);
#pragma unroll
        for (int rg = 0; rg < 4; ++rg) { const int s = 4 * g + rg; const bool keep = d ? (s >= c) : (s <= c); const float e = __expf(fminf(cint - cin4[rg], 0.f)); sT[rg] = keep ? sT[rg] * e : 0.f; }
        const v2u xt = lds8(bd + SS_XT + (pt * 16 + c) * 32 + 8 * g);
        acc = __builtin_amdgcn_mfma_f32_16x16x32_bf16(mk8(pk4h(sT), (v2u){0u, 0u}), mk8(xt, (v2u){0u, 0u}), acc, 0, 0, 0);
        f4 dt4 = (f4){1.f, 1.f, 1.f, 1.f}; if (d == 0) dt4 = *(const LAS f4*)(buf + SS_DTV + 16 * g);
#pragma unroll
        for (int rg = 0; rg < 4; ++rg) { float o = acc[rg];
            if (d == 0) { const unsigned w = rg < 2 ? xt.x : xt.y; const float xd = (rg & 1) ? bfhi(w) : bflo(w); o += Dh * xd / dt4[rg]; }
            if (rmw) o += bf2f(oo[rg]);
            YO[(m0 + 4 * g + rg) * 256] = (bf16)f2bf(o); }
        const bf16x8 Bw = mk8(lds8(bd + SS_XW + (pt * 16 + c) * 32 + 8 * g), (v2u){0u, 0u});
#pragma unroll
        for (int nt = 0; nt < 8; ++nt) st[nt] = __builtin_amdgcn_mfma_f32_16x16x32_bf16(mk8(lds8(bd + SS_BT + (16 * nt + c) * 32 + 8 * g), (v2u){0u, 0u}), Bw, st[nt] * gg, 0, 0, 0);
    };
    SS_FETCH(a, 0); SS_FETCH(b, 1);
#pragma unroll 1
    for (int ib = 0; ib < nb; ib += 2) {
        SS_PUT(a, C.lds); __syncthreads(); if (ib + 2 < nb) SS_FETCH(a, ib + 2); compute(ib, C.lds);
        SS_PUT(b, C.lds + SS_BUF); __syncthreads(); if (ib + 3 < nb) SS_FETCH(b, ib + 3); compute(ib + 1, C.lds + SS_BUF);
    }
#undef SS_PUT
#undef SS_FETCH
    if (!lat) {
#pragma unroll
        for (int nt = 0; nt < 8; ++nt) *(GAS f32x4*)(C.out + O_SSS + ((((size_t)(b * 4 + l) * 2 + d) * 4 + h) * 64 + pt * 16 + c) * 128 + 16 * nt + 4 * g) = st[nt];
    }
    __syncthreads();
}
__device__ __forceinline__ void lr_wave(const Ctx& C, int l, int job) {
    const int cb = job & 3, d = (job >> 2) & 1, sq = job >> 3, lat = sq >= 32, b = lat ? sq - 32 : sq, c = cb * 64 + C.lane;
    const int T = lat ? TL : TC, ms = lat ? MC + b * TL : b * TC, nb = T / 16, blk0 = ms / 16;
    const float* AE = WSP(const float, WS_LR_AE) + ((size_t)d * NBLK + blk0) * 256 + c; const float* HE = WSP(const float, WS_LR_HE) + ((size_t)d * NBLK + blk0) * 256 + c;
    float* HIN = WSP(float, WS_LR_HIN) + ((size_t)d * NBLK + blk0) * 256 + c;
    float hs = lat ? INP(I_SLR)[((size_t)(b * 4 + l) * 2 + d) * 256 + c] : 0.f;
#pragma unroll 1
    for (int i0 = 0; i0 < nb; i0 += 8) {
        float a[8], e[8];
#pragma unroll
        for (int i = 0; i < 8; ++i) { const int blk = d ? nb - 1 - (i0 + i) : i0 + i; a[i] = AE[(size_t)blk * 256]; e[i] = HE[(size_t)blk * 256]; }
#pragma unroll
        for (int i = 0; i < 8; ++i) { const int blk = d ? nb - 1 - (i0 + i) : i0 + i; HIN[(size_t)blk * 256] = hs; hs = a[i] * hs + e[i]; }
    }
    if (!lat) C.out[O_SLR + ((size_t)(b * 4 + l) * 2 + d) * 256 + c] = hs;
}

__device__ __forceinline__ void run_job(const Ctx& C0, int l, int kind, int id) {
    Ctx C = C0; { int t_ = C0.tid; asm volatile("" : "+v"(t_)); C.tid = t_; C.lane = t_ & 63; C.wave = __builtin_amdgcn_readfirstlane(t_ >> 6); }
#ifndef JOBEN
#define JOBEN 7
#endif
    if (kind == 0) { if (!(JOBEN & 1)) return; const int lt = id >= 512 ? 1 : 0; id -= lt * 512; for (int rep = 0; rep < NREP(12); ++rep) scan_rwkv(C, l, lt, id >> 4, (id >> 3) & 1, (id >> 1) & 3, id & 1); }
    else { const int lt = id >= 128 ? 1 : 0; id -= lt * 128; if (kind == 1) { if (JOBEN & 2) for (int rep = 0; rep < NREP(13); ++rep) ss_job(C, l, lt, id >> 2, id & 3); } else { if (JOBEN & 4) for (int rep = 0; rep < NREP(14); ++rep) hg_job(C, l, lt, id >> 2, id & 3); } }
}
__device__ __forceinline__ void phase_scans(const Ctx& C, int l) {
    int w = C.wg; asm volatile("" : "+s"(w)); const int G = C.G;
    { const int gw = (w >= 64 ? w - 64 : w + G - 64) * NWAVES + C.wave;
#pragma unroll 1
      for (int j = gw; j < 288; j += G * NWAVES) lr_wave(C, l, j); }
    if (G == 256) {
#pragma unroll 1
        for (int i = 0; i < 5; ++i) {
            int kind = -1, id = 0;
            if (w < 64) { if (i == 0) { kind = 0; id = 512 + w; } }
            else if (w < 96) { const int x = w - 64; if (i == 0) { kind = 1 + (x >> 4); id = 128 + (x & 15); } else if (i == 1) { kind = 0; id = 480 + x; } }
            else { const int k = w - 96; if (i < 3) { kind = 0; id = k + 160 * i; } else { const int e = k + 160 * (i - 3); if (e < 256) { kind = 1 + (e >> 7); id = e & 127; } } }
            kind = __builtin_amdgcn_readfirstlane(kind); id = __builtin_amdgcn_readfirstlane(id);
            asm volatile("" : "+s"(kind), "+s"(id));
            if (kind >= 0) run_job(C, l, kind, id);
        }
    } else {
#pragma unroll 1
        for (int j = w; j < 576 + 288; j += G) { int kind = j < 576 ? 0 : (j < 720 ? 1 : 2), id = j < 576 ? j : (j < 720 ? j - 576 : j - 720); kind = __builtin_amdgcn_readfirstlane(kind); id = __builtin_amdgcn_readfirstlane(id); asm volatile("" : "+s"(kind), "+s"(id)); run_job(C, l, kind, id); }
    }
}

__device__ __forceinline__ void ld4bf(const bf16* p, float (&o)[4]) { const unsigned long long w = *(const GAS unsigned long long*)p; o[0] = bflo((unsigned)w); o[1] = bfhi((unsigned)w); o[2] = bflo((unsigned)(w >> 32)); o[3] = bfhi((unsigned)(w >> 32)); }
__device__ __forceinline__ void st4bf(bf16* p, const float (&o)[4]) { *(GAS unsigned long long*)p = (unsigned long long)pk2(o[0], o[1]) | ((unsigned long long)pk2(o[2], o[3]) << 32); }
__device__ __forceinline__ void phase_post(const Ctx& C, int l) {
    const int gw = C.wg * NWAVES + C.wave, NGW = C.G * NWAVES, lane = C.lane, c4 = 4 * lane, h = lane >> 4;
    const bf16* YS = WSP(const bf16, WS_YS); const bf16* PROJ = WSP(const bf16, WS_PROJ); bf16* MIX = WSP(bf16, WS_MIX);
    const f4 lnw = *(const GAS f4*)(INP(I_RWLNW) + l * 256 + c4), lnb = *(const GAS f4*)(INP(I_RWLNB) + l * 256 + c4), hgn = *(const GAS f4*)(INP(I_HGNORM) + l * 256 + c4), ssn = *(const GAS f4*)(INP(I_SSNORM) + l * 256 + c4);
    const size_t YA = (size_t)MT * 256;
#pragma unroll 1
    for (int m = gw; m < MT; m += NGW) {
        const size_t mo = (size_t)m * 256 + c4; const size_t gb = (size_t)(m >> 4); float a[4], b[4], o[4];
        { ld4bf(YS + 0 * YA + mo, a); ld4bf(YS + 1 * YA + mo, b); float y[4], s = 0.f;
#pragma unroll
          for (int i = 0; i < 4; ++i) { y[i] = a[i] + b[i]; s += y[i]; }
          const float mean = sum16(s) * (1.f / 64.f); float qv = 0.f;
#pragma unroll
          for (int i = 0; i < 4; ++i) { y[i] -= mean; qv += y[i] * y[i]; }
          const float rs = rsqrtf(sum16(qv) * (1.f / 64.f) + 64e-5f);
          float vv[4], gg[4]; ld4bf(WSP(const bf16, WS_RW_V) + mo, vv); ld4bf(WSP(const bf16, WS_RW_G) + mo, gg);
          const float bon = WSP(const float, WS_RW_BON)[(size_t)m * 4 + h];
#pragma unroll
          for (int i = 0; i < 4; ++i) o[i] = (y[i] * rs * lnw[i] + lnb[i] + bon * vv[i]) * gg[i];
          st4bf(MIX + (size_t)m * DM + c4, o); }
        { ld4bf(YS + 2 * YA + mo, a); float s = 0.f;
#pragma unroll
          for (int i = 0; i < 4; ++i) s += a[i] * a[i];
          const float rs = rsqrtf(wave_sum(s) * (1.f / 256.f) + 1e-6f);
          float gp[4]; ld4bf(PROJ + (size_t)m * PINP + C_HG_G + c4, gp);
#pragma unroll
          for (int i = 0; i < 4; ++i) o[i] = a[i] * rs * hgn[i] * siluf_(gp[i]);
          st4bf(MIX + (size_t)m * DM + 256 + c4, o); }
        { ld4bf(YS + 3 * YA + mo, a); float zz[4], y[4], s = 0.f; ld4bf(PROJ + (size_t)m * PINP + C_SS_Z + c4, zz);
#pragma unroll
          for (int i = 0; i < 4; ++i) { y[i] = a[i] * siluf_(zz[i]); s += y[i] * y[i]; }
          const float rs = rsqrtf(wave_sum(s) * (1.f / 256.f) + 1e-6f);
#pragma unroll
          for (int i = 0; i < 4; ++i) o[i] = y[i] * rs * ssn[i];
          st4bf(MIX + (size_t)m * DM + 512 + c4, o); }
        { float al[4], hl[4], yb[4]; ld4bf(PROJ + (size_t)m * PINP + C_LR_Y + c4, yb);
          const f4 h0 = *(const GAS f4*)(WSP(const float, WS_LR_HIN) + gb * 256 + c4), h1 = *(const GAS f4*)(WSP(const float, WS_LR_HIN) + ((size_t)NBLK + gb) * 256 + c4);
          ld4bf(WSP(const bf16, WS_LR_AL) + mo, al); ld4bf(WSP(const bf16, WS_LR_HL) + mo, hl);
#pragma unroll
          for (int i = 0; i < 4; ++i) o[i] = al[i] * h0[i] + hl[i];
          ld4bf(WSP(const bf16, WS_LR_AL) + YA + mo, al); ld4bf(WSP(const bf16, WS_LR_HL) + YA + mo, hl);
#pragma unroll
          for (int i = 0; i < 4; ++i) o[i] = (o[i] + al[i] * h1[i] + hl[i]) * gelu_tanh(yb[i]);
          st4bf(MIX + (size_t)m * DM + 768 + c4, o); }
    }
}

struct Args { const float* in[N_IN]; float* out; unsigned char* ws; int ph_lo, ph_hi; };
constexpr int N_PHASES = 2 + 9 * DEPTH;
#ifndef MKEN
#define MKEN 0xFFFF
#endif
#define EN(x) ((MKEN >> (x)) & 1)

__global__ void __launch_bounds__(NWAVES * 64, 2) mk_fwd(Args args) {
    extern __shared__ __attribute__((aligned(16))) unsigned char lds_raw[];
    Ctx C;
    C.out = args.out; C.ws = args.ws;
    C.lds = (LAS unsigned char*)lds_raw;
    C.tid = threadIdx.x; C.lane = C.tid & 63; C.wave = __builtin_amdgcn_readfirstlane(C.tid >> 6);
    C.G = gridDim.x; C.wg = blockIdx.x;
    volatile LAS unsigned* MISC = (volatile LAS unsigned*)(C.lds + MISC_OFF);
    for (int u = C.tid; u < (LDS_BYTES - LDSCTL_OFF) / 4; u += NWAVES * 64) ((LAS unsigned*)(C.lds + LDSCTL_OFF))[u] = 0u;
    __syncthreads();
    if (C.tid == 0) {
#pragma unroll
        for (int i = 0; i < N_IN; ++i) *(LAS unsigned long long*)(C.lds + PTAB_OFF + 8 * i) = (unsigned long long)args.in[i];
    }
    __syncthreads();
    const int lo = args.ph_lo, hi = args.ph_hi;
    XcdBarrier bar; bar.bar = (unsigned*)(C.ws + WS_CTL) + CW_BAR; bar.x = 0; bar.st = nullptr;
    if (hi - lo > 1) bar = xcd_barrier_post((unsigned*)(C.ws + WS_CTL) + CW_BAR, MISC + 8);
#define IN(k) (lo <= (k) && (k) < hi)
#define SEAM(k) do { if (IN(k) && IN((k) + 1)) xcd_barrier(bar); RELAUNDER(); } while (0)
#define RELAUNDER() do { int t_ = threadIdx.x; asm volatile("" : "+v"(t_)); C.tid = t_; C.lane = t_ & 63; C.wave = __builtin_amdgcn_readfirstlane(t_ >> 6); } while (0)
    if (EN(0) && IN(0)) { for (int rep = 0; rep < NREP(0); ++rep) p0_prologue(C); } SEAM(0);
    if (EN(1) && IN(1)) { phase_norm_in(C); } SEAM(1);
#pragma unroll 1
    for (int l = 0; l < DEPTH; ++l) {
        const int p0 = 2 + 9 * l;
        if (EN(2) && IN(p0 + 0)) {
            pg8::Gemm g{WSP(const bf16, WS_H), WSP(const bf16, WS_WIN) + (size_t)l * PINP * DM, MT, PINP, DM}; pg8::StaticOrder S; S.init(MT, PINP, C.G, C.wg);
            pg8::EpiBf16<0> E{WSP(bf16, WS_PROJ), PINP};
            for (int rep = 0; rep < NREP(2); ++rep) pg8::gemm_phase<pg8::EpiBf16<0>, pg8::StaticOrder, PG8_ALIGN, PG8_SP2>(C.lds, g, S, E);
        } SEAM(p0 + 0);
        if (EN(3) && IN(p0 + 1)) { for (int rep = 0; rep < NREP(3); ++rep) phase_prep(C, l); } SEAM(p0 + 1);
        if (EN(4) && IN(p0 + 2)) { for (int rep = 0; rep < NREP(4); ++rep) phase_scans(C, l); } SEAM(p0 + 2);
        if (EN(5) && IN(p0 + 3)) { for (int rep = 0; rep < NREP(5); ++rep) phase_post(C, l); } SEAM(p0 + 3);
        if (EN(6) && IN(p0 + 4)) {
            pg8::Gemm g{WSP(const bf16, WS_MIX), WSP(const bf16, WS_WOUT) + (size_t)l * DM * DM, MT, DM, DM}; pg8::StaticOrder S; S.init(MT, DM, C.G, C.wg);
            pg8::EpiF32 E{WSP(float, WS_GO), DM};
            for (int rep = 0; rep < NREP(2); ++rep) pg8::gemm_phase<pg8::EpiF32, pg8::StaticOrder, PG8_ALIGN, PG8_SP2>(C.lds, g, S, E);
        } SEAM(p0 + 4);
        if (EN(7) && IN(p0 + 5)) { phase_norm_res(C, l, 0); } SEAM(p0 + 5);
        if (EN(8) && IN(p0 + 6)) {
            pg8::Gemm g{WSP(const bf16, WS_H), WSP(const bf16, WS_W1) + (size_t)l * FFD * DM, MT, FFD, DM}; pg8::StaticOrder S; S.init(MT, FFD, C.G, C.wg);
            pg8::EpiBf16<2> E{WSP(bf16, WS_U), FFD};
            for (int rep = 0; rep < NREP(2); ++rep) pg8::gemm_phase<pg8::EpiBf16<2>, pg8::StaticOrder, PG8_ALIGN, PG8_SP2>(C.lds, g, S, E);
        } SEAM(p0 + 6);
        if (EN(9) && IN(p0 + 7)) {
            pg8::Gemm g{WSP(const bf16, WS_U), WSP(const bf16, WS_W2) + (size_t)l * DM * FFD, MT, DM, FFD}; pg8::StaticOrder S; S.init(MT, DM, C.G, C.wg);
            pg8::EpiF32 E{WSP(float, WS_GO), DM};
            for (int rep = 0; rep < NREP(2); ++rep) pg8::gemm_phase<pg8::EpiF32, pg8::StaticOrder, PG8_ALIGN, PG8_SP2>(C.lds, g, S, E);
        } SEAM(p0 + 7);
        if (EN(10) && IN(p0 + 8)) { phase_norm_res(C, l, 1); } SEAM(p0 + 8);
    }
#undef IN
#undef SEAM
}

extern "C" void kernel_launch(void* const* d_in, const int* in_sizes, int n_in, void* d_out, int out_size, void* d_ws, size_t ws_size, hipStream_t stream) {
    static int grid = 0;
    if (grid == 0) {
        if (n_in != N_IN || (size_t)out_size != O_END || ws_size < WS_END) { fprintf(stderr, "kernel_launch: unexpected shapes: n_in %d out %d ws %zu (need %zu)\n", n_in, out_size, ws_size, (size_t)WS_END); grid = -1; return; }
        int dev = 0, cus = 0, per_cu = 0;
        if (hipGetDevice(&dev) != hipSuccess || hipDeviceGetAttribute(&cus, hipDeviceAttributeMultiprocessorCount, dev) != hipSuccess) { grid = -1; return; }
        if (hipFuncSetAttribute((const void*)mk_fwd, hipFuncAttributeMaxDynamicSharedMemorySize, LDS_BYTES) != hipSuccess) { fprintf(stderr, "kernel_launch: hipFuncSetAttribute failed\n"); grid = -1; return; }
        if (hipOccupancyMaxActiveBlocksPerMultiprocessor(&per_cu, (const void*)mk_fwd, NWAVES * 64, LDS_BYTES) != hipSuccess || per_cu < 1) { fprintf(stderr, "kernel_launch: occupancy query says %d blocks per CU\n", per_cu); (void)hipGetLastError(); grid = -1; return; }
        grid = cus;
    }
    if (grid < 0) return;
    if (hipMemsetAsync((char*)d_ws + WS_CTL, 0, CTL_ZERO_BYTES, stream) != hipSuccess) return;
    Args a{};
    for (int i = 0; i < N_IN; ++i) a.in[i] = (const float*)d_in[i];
    a.out = (float*)d_out; a.ws = (unsigned char*)d_ws;
#if MK_SINGLE
    a.ph_lo = 0; a.ph_hi = N_PHASES;
    void* kargs[] = {&a};
    hipError_t e = hipLaunchCooperativeKernel((const void*)mk_fwd, dim3(grid), dim3(NWAVES * 64), kargs, LDS_BYTES, stream);
    if (e != hipSuccess) fprintf(stderr, "kernel_launch: cooperative launch failed: %s (grid %d)\n", hipGetErrorString(e), grid);
#else
    for (int p = 0; p < N_PHASES; ++p) { a.ph_lo = p; a.ph_hi = p + 1; hipLaunchKernelGGL(mk_fwd, dim3(grid), dim3(NWAVES * 64), LDS_BYTES, stream, a); }
#endif
}
```
